# Optimizing an MI355X kernel written in HIP

```python
import jax, jax.numpy as jnp
from jax import lax
import numpy as np

D_MODEL = 2048
BATCH = 2
SEQ = 4096
DEPTH = 1

GRID_W = 64
CTX_LEN = 256
HG_HEADS = 8
HG_DK = 128
HG_DV = 128
HG_WIDTH = HG_HEADS * HG_DV
HG_CHUNK = 32
ATT_HEADS = 8
ATT_KV_HEADS = 2
HEAD_DIM = 128
ATT_WIDTH = ATT_HEADS * HEAD_DIM
WINDOW = 128
ATT_BLOCK = 128
ROPE_THETA = 10000.0
D_MIX = HG_WIDTH + ATT_WIDTH
HG_COLS = 3 * HG_HEADS * HG_DK + 2 * HG_HEADS * HG_DV
ATT_COLS = (ATT_HEADS + 2 * ATT_KV_HEADS) * HEAD_DIM
IN_COLS = HG_COLS + ATT_COLS
D_FF = ((8 * D_MODEL + 3 * 256 - 1) // (3 * 256)) * 256
N_MOD = 6
RMS_EPS = 1e-6
NEG_INF = -1e30
LB_SLACK = 1.0

kernel_name = "hymba_style_hgrn2_window_gqa_dit_block"


def rms_norm(x, g):
    xf = x.astype(jnp.float32)
    y = xf * lax.rsqrt(jnp.mean(xf * xf, axis=-1, keepdims=True) + RMS_EPS)
    return (y * g.astype(jnp.float32)).astype(x.dtype)


def modulate(h, shift, scale):
    return h * (1 + scale) + shift


def axial_rope(x, row, col):
    half = HEAD_DIM // 2
    nf = half // 2
    inv_freq = ROPE_THETA ** (-jnp.arange(nf, dtype=jnp.float32) / nf)
    extra = (1,) * (x.ndim - 3)

    def rotate(xa, pos):
        ang = pos.astype(jnp.float32)[:, None] * inv_freq
        cos = jnp.cos(ang).reshape((1, -1) + extra + (nf,))
        sin = jnp.sin(ang).reshape((1, -1) + extra + (nf,))
        x1 = xa[..., :nf].astype(jnp.float32)
        x2 = xa[..., nf:].astype(jnp.float32)
        return jnp.concatenate([x1 * cos - x2 * sin, x1 * sin + x2 * cos], axis=-1)

    out = jnp.concatenate([rotate(x[..., :half], row), rotate(x[..., half:], col)], axis=-1)
    return out.astype(x.dtype)


def chunked_gated_linear_scan(q, k, v, log_f, s0):
    B, H, T, DK = q.shape
    DV = v.shape[-1]
    N = T // HG_CHUNK
    q = q.reshape(B, H, N, HG_CHUNK, DK)
    k = k.reshape(B, H, N, HG_CHUNK, DK)
    v = v.reshape(B, H, N, HG_CHUNK, DV)
    b = jnp.cumsum(log_f.reshape(B, H, N, HG_CHUNK, DK), axis=3)
    b_last = b[:, :, :, -1:, :]
    q_dec = q * jnp.exp(b)
    k_inv = k * jnp.exp(-b)
    causal_in_chunk = jnp.tril(jnp.ones((HG_CHUNK, HG_CHUNK), dtype=bool))
    scores = jnp.einsum('bhnck,bhnsk->bhncs', q_dec, k_inv)
    scores = jnp.where(causal_in_chunk, scores, 0.0)
    o_intra = jnp.einsum('bhncs,bhnsv->bhncv', scores, v)
    kv_chunk = jnp.einsum('bhnsk,bhnsv->bhnkv', k * jnp.exp(b_last - b), v)
    decay = jnp.exp(b_last[:, :, :, 0, :])

    def step(s, inp):
        d, u = inp
        return d[..., None] * s + u, s

    s_final, s_starts = lax.scan(step, s0, (jnp.moveaxis(decay, 2, 0), jnp.moveaxis(kv_chunk, 2, 0)))
    s_starts = jnp.moveaxis(s_starts, 0, 2)
    o_inter = jnp.einsum('bhnck,bhnkv->bhncv', q_dec, s_starts)
    return (o_intra + o_inter).reshape(B, H, T, DV), s_final


def reverse_gated_linear_scan(q, k, v, log_f, s0):
    flip = lambda a: jnp.flip(a, axis=2)
    o, s = chunked_gated_linear_scan(flip(q), flip(k), flip(v), flip(log_f), s0)
    return flip(o), s


def hgrn2_mixer(p_lat, p_ctx, lb, norm_g, need_ctx_out):
    splits = [HG_HEADS * HG_DK, 2 * HG_HEADS * HG_DK, 3 * HG_HEADS * HG_DK,
              3 * HG_HEADS * HG_DK + HG_HEADS * HG_DV]

    def prep(p):
        B, T, _ = p.shape
        heads = lambda a: a.reshape(B, T, HG_HEADS, -1).transpose(0, 2, 1, 3).astype(jnp.float32)
        q, f_fwd, f_bwd, i, g = jnp.split(p, splits, axis=-1)
        q = jax.nn.silu(heads(q))
        gates = []
        for d, f_pre in enumerate((f_fwd, f_bwd)):
            lb_d = lb[d].reshape(HG_HEADS, 1, HG_DK)
            f = lb_d + (1.0 - lb_d) * jax.nn.sigmoid(heads(f_pre))
            gates.append((1.0 - f, jnp.log(f)))
        return q, heads(i), gates, g

    def readout(o, g):
        B, H, T, DV = o.shape
        o = rms_norm(o, norm_g).transpose(0, 2, 1, 3).reshape(B, T, H * DV)
        return (o * jax.nn.silu(g.astype(jnp.float32))).astype(g.dtype)

    qc, ic, (gc_f, gc_b), g_c = prep(p_ctx)
    ql, il, (gl_f, gl_b), g_l = prep(p_lat)
    B = p_lat.shape[0]
    zero = jnp.zeros((B, HG_HEADS, HG_DK, HG_DV), jnp.float32)
    oc_f, s_ctx_f = chunked_gated_linear_scan(qc, gc_f[0], ic, gc_f[1], zero)
    oc_b, s_ctx_b = reverse_gated_linear_scan(qc, gc_b[0], ic, gc_b[1], zero)
    ol_f, _ = chunked_gated_linear_scan(ql, gl_f[0], il, gl_f[1], s_ctx_f)
    ol_b, _ = reverse_gated_linear_scan(ql, gl_b[0], il, gl_b[1], s_ctx_b)
    lat_out = readout(ol_f + ol_b, g_l)
    ctx_out = readout(oc_f + oc_b, g_c) if need_ctx_out else None
    return lat_out, ctx_out


def window_attention(p_lat, p_ctx, q_g, k_g, sink, row, col, need_ctx_out):
    G = ATT_HEADS // ATT_KV_HEADS
    scale = HEAD_DIM ** -0.5

    def split_heads(p):
        B, T, _ = p.shape
        q, k, v = jnp.split(p, [ATT_HEADS * HEAD_DIM, (ATT_HEADS + ATT_KV_HEADS) * HEAD_DIM], axis=-1)
        q = rms_norm(q.reshape(B, T, ATT_KV_HEADS, G, HEAD_DIM), q_g)
        k = rms_norm(k.reshape(B, T, ATT_KV_HEADS, HEAD_DIM), k_g)
        return q, k, v.reshape(B, T, ATT_KV_HEADS, HEAD_DIM)

    ql, kl, vl = split_heads(p_lat)
    qc, kc, vc = split_heads(p_ctx)
    ql = axial_rope(ql, row, col)
    kl = axial_rope(kl, row, col)
    B, T = p_lat.shape[:2]
    L = p_ctx.shape[1]
    NB = T // ATT_BLOCK
    sink_f = sink.astype(jnp.float32).reshape(ATT_KV_HEADS, G, 1, 1)

    qb = ql.reshape(B, NB, ATT_BLOCK, ATT_KV_HEADS, G, HEAD_DIM)
    pad = ((0, 0), (ATT_BLOCK, ATT_BLOCK), (0, 0), (0, 0))
    kp = jnp.pad(kl, pad).reshape(B, NB + 2, ATT_BLOCK, ATT_KV_HEADS, HEAD_DIM)
    vp = jnp.pad(vl, pad).reshape(B, NB + 2, ATT_BLOCK, ATT_KV_HEADS, HEAD_DIM)
    k_band = jnp.concatenate([kp[:, :-2], kp[:, 1:-1], kp[:, 2:]], axis=2)
    v_band = jnp.concatenate([vp[:, :-2], vp[:, 1:-1], vp[:, 2:]], axis=2)
    s_band = jnp.einsum('bnqhgd,bnkhd->bhgnqk', qb, k_band).astype(jnp.float32) * scale
    s_ctx = jnp.einsum('bnqhgd,bkhd->bhgnqk', qb, kc).astype(jnp.float32) * scale
    qi = jnp.arange(ATT_BLOCK)[:, None]
    kj = jnp.arange(3 * ATT_BLOCK)[None, :]
    within = jnp.abs(kj - ATT_BLOCK - qi) <= WINDOW
    k_pos = (jnp.arange(NB)[:, None] - 1) * ATT_BLOCK + kj
    in_range = (k_pos >= 0) & (k_pos < T)
    mask = within[None, :, :] & in_range[:, None, :]
    s_band = jnp.where(mask, s_band, NEG_INF)
    sink_col = jnp.broadcast_to(sink_f[None, :, :, :, :, None], s_band.shape[:-1] + (1,))
    probs = jax.nn.softmax(jnp.concatenate([s_band, s_ctx, sink_col], axis=-1), axis=-1)
    p_band = probs[..., :3 * ATT_BLOCK].astype(vl.dtype)
    p_ctxk = probs[..., 3 * ATT_BLOCK:3 * ATT_BLOCK + L].astype(vc.dtype)
    o_lat = (jnp.einsum('bhgnqk,bnkhd->bnqhgd', p_band, v_band)
             + jnp.einsum('bhgnqk,bkhd->bnqhgd', p_ctxk, vc))
    lat_out = o_lat.reshape(B, T, ATT_WIDTH)

    ctx_out = None
    if need_ctx_out:
        sc = jnp.einsum('bqhgd,bkhd->bhgqk', qc, kc).astype(jnp.float32) * scale
        sink_c = jnp.broadcast_to(sink_f[None, :, :, :, :], sc.shape[:-1] + (1,))
        pc = jax.nn.softmax(jnp.concatenate([sc, sink_c], axis=-1), axis=-1)[..., :L]
        o_c = jnp.einsum('bhgqk,bkhd->bqhgd', pc.astype(vc.dtype), vc)
        ctx_out = o_c.reshape(B, L, ATT_WIDTH)
    return lat_out, ctx_out


def swiglu(h, w_gate_up, w_down):
    gate, up = jnp.split(h @ w_gate_up, 2, axis=-1)
    return (jax.nn.silu(gate) * up) @ w_down


def setup_inputs(seed: int = 0) -> dict:
    key = jax.random.key(seed)
    ks = jax.random.split(key, 17)
    nrm = lambda k, shape, s: s * jax.random.normal(k, shape, jnp.float32)
    hg_lb = nrm(ks[9], (DEPTH + 1, 2, HG_HEADS * HG_DK), 0.1).at[DEPTH].add(LB_SLACK)
    return {
        "x": nrm(ks[0], (BATCH, SEQ, D_MODEL), 1.0),
        "c": nrm(ks[1], (BATCH, D_MODEL), 1.0),
        "ctx": nrm(ks[2], (BATCH, CTX_LEN, D_MODEL), 1.0),
        "c_ctx": nrm(ks[3], (D_MODEL,), 1.0),
        "w_mod": nrm(ks[4], (DEPTH, D_MODEL, N_MOD * D_MODEL), 0.5 * D_MODEL ** -0.5),
        "b_mod": nrm(ks[5], (DEPTH, N_MOD * D_MODEL), 0.01),
        "norm_mix_g": 1.0 + nrm(ks[6], (DEPTH, D_MODEL), 0.05),
        "norm_ffn_g": 1.0 + nrm(ks[7], (DEPTH, D_MODEL), 0.05),
        "w_in": nrm(ks[8], (DEPTH, D_MODEL, IN_COLS), D_MODEL ** -0.5),
        "hg_lb": hg_lb,
        "hg_norm_g": 1.0 + nrm(ks[10], (DEPTH, HG_DV), 0.05),
        "q_norm_g": 1.0 + nrm(ks[11], (DEPTH, HEAD_DIM), 0.05),
        "k_norm_g": 1.0 + nrm(ks[12], (DEPTH, HEAD_DIM), 0.05),
        "attn_sink": nrm(ks[13], (DEPTH, ATT_HEADS), 1.0),
        "w_out": nrm(ks[14], (DEPTH, D_MIX, D_MODEL), D_MIX ** -0.5),
        "w_gate_up": nrm(ks[15], (DEPTH, D_MODEL, 2 * D_FF), D_MODEL ** -0.5),
        "w_down": nrm(ks[16], (DEPTH, D_FF, D_MODEL), D_FF ** -0.5),
    }


def reference(x, c, ctx, c_ctx, w_mod, b_mod, norm_mix_g, norm_ffn_g, w_in, hg_lb,
              hg_norm_g, q_norm_g, k_norm_g, attn_sink, w_out, w_gate_up, w_down):
    T = x.shape[1]
    rows = T // GRID_W
    row = jnp.broadcast_to(jnp.arange(rows)[:, None], (rows, GRID_W)).reshape(-1)
    col = jnp.broadcast_to(jnp.arange(GRID_W)[None, :], (rows, GRID_W)).reshape(-1)
    lb_all = jnp.cumsum(jax.nn.softmax(hg_lb.astype(jnp.float32), axis=0), axis=0)
    y = ctx
    for l in range(DEPTH):
        need_ctx_out = l < DEPTH - 1
        sh_m, sc_m, gt_m, sh_f, sc_f, gt_f = [m[:, None, :] for m in
            jnp.split(jax.nn.silu(c) @ w_mod[l] + b_mod[l], N_MOD, axis=-1)]
        csh_m, csc_m, cgt_m, csh_f, csc_f, cgt_f = jnp.split(
            jax.nn.silu(c_ctx) @ w_mod[l] + b_mod[l], N_MOD, axis=-1)

        h_lat = modulate(rms_norm(x, norm_mix_g[l]), sh_m, sc_m)
        h_ctx = modulate(rms_norm(y, norm_mix_g[l]), csh_m, csc_m)
        p_lat = h_lat @ w_in[l]
        p_ctx = h_ctx @ w_in[l]
        hg_lat, hg_ctx = hgrn2_mixer(p_lat[..., :HG_COLS], p_ctx[..., :HG_COLS],
                                     lb_all[l], hg_norm_g[l], need_ctx_out)
        at_lat, at_ctx = window_attention(p_lat[..., HG_COLS:], p_ctx[..., HG_COLS:],
                                          q_norm_g[l], k_norm_g[l], attn_sink[l],
                                          row, col, need_ctx_out)
        x = x + gt_m * (jnp.concatenate([hg_lat, at_lat], axis=-1) @ w_out[l])

        x = x + gt_f * swiglu(modulate(rms_norm(x, norm_ffn_g[l]), sh_f, sc_f),
                              w_gate_up[l], w_down[l])

        if need_ctx_out:
            y = y + cgt_m * (jnp.concatenate([hg_ctx, at_ctx], axis=-1) @ w_out[l])
            y = y + cgt_f * swiglu(modulate(rms_norm(y, norm_ffn_g[l]), csh_f, csc_f),
                                   w_gate_up[l], w_down[l])
    return x
```

```cpp
#define N_LAUNCH 1
#include <hip/hip_runtime.h>
#include <hip/hip_cooperative_groups.h>
#include <cstdio>
#include <cstdint>
namespace cg = cooperative_groups;
namespace pg8 {
#define PG8_LAS __attribute__((address_space(3)))
typedef unsigned short bf16_t;
typedef short bf16x8 __attribute__((ext_vector_type(8)));
typedef float f32x4 __attribute__((ext_vector_type(4)));
typedef unsigned u32x4 __attribute__((ext_vector_type(4)));
constexpr int BM = 256, BK = 64, HALF = 128, HTB = HALF * BK * 2  , STAGE_BYTES = 8 * HTB, NXCD = 8, WGM = 8;

__host__ __device__ __forceinline__ int lds_byte(int r, int c) { const int st = (r >> 4) * 2 + (c >> 5), rr = r & 15, cc = c & 31, ob = rr * 64 + cc * 2; return st * 1024 + (ob ^ (((ob >> 9) & 1) << 5)); }
__host__ __device__ __forceinline__ void stage_rc(int b, int& R, int& C) { const int st = b / 1024, sb = b % 1024, swz = sb ^ (((sb >> 9) & 1) << 5); R = (st >> 1) * 16 + swz / 64; C = (st & 1) * 32 + (swz % 64) / 2; }
__host__ __device__ __forceinline__ int perm32(int rho) { const int n = rho >> 4, i = rho & 15; return 8 * (i >> 2) + 4 * n + (i & 3); }

struct Unit { int pm, pn; };
struct Gemm { const bf16_t* A; const bf16_t* Bt; int M, N, K; };

struct StaticOrder {
    int nM, nN, nwg, G, c;
    __host__ __device__ void init(int M, int N, int G_, int c_) { nM = M / BM; nN = N / BM; nwg = nM * nN; G = G_; c = c_; }
    __host__ __device__ bool next(int i, Unit& u) const {
        const long L = (long)i * G + c; if (L >= nwg) return false;
        int wgid = (int)L; { const int q = nwg / NXCD, r = nwg % NXCD, xcd = wgid % NXCD, off = wgid / NXCD; wgid = (xcd < r ? xcd * (q + 1) : r * (q + 1) + (xcd - r) * q) + off; }
        const int nig = WGM * nN, gid = wgid / nig, fm = gid * WGM, gsz = (nM - fm) < WGM ? (nM - fm) : WGM;
        u.pm = fm + ((wgid % nig) % gsz); u.pn = (wgid % nig) / gsz; return true;
    }
    __device__ __forceinline__ void a_ready(const Unit&) const {}
    __device__ __forceinline__ void done(const Unit&) const {}
};

__device__ __forceinline__ unsigned cvt_pk_bf16(float lo, float hi) { unsigned r; asm volatile("v_cvt_pk_bf16_f32 %0, %1, %2" : "=v"(r) : "v"(lo), "v"(hi)); return r; }
typedef float f32x2 __attribute__((ext_vector_type(2)));
__device__ __forceinline__ f32x2 gelu_pk(f32x2 v) {
    const f32x2 av = __builtin_elementwise_abs(v), d = av * 0.2316418882f + 1.0f;
    f32x2 t; t.x = __builtin_amdgcn_rcpf(d.x); t.y = __builtin_amdgcn_rcpf(d.y);
    f32x2 q = t * 0.5307027145f + (-0.7265760135f); q = q * t + 0.7107068705f; q = q * t + (-0.142248368f); q = q * t + 0.127414796f; q = q * t;
    const f32x2 s = (v * v) * (-0.72134752044f);
    f32x2 e; e.x = __builtin_amdgcn_exp2f(s.x); e.y = __builtin_amdgcn_exp2f(s.y);
    const f32x2 m = v * (q * e), r = v - m;
    f32x2 o; o.x = v.x < 0.f ? m.x : r.x; o.y = v.y < 0.f ? m.y : r.y; return o;
}

template <int ACT  > struct EpiBf16 {
    static constexpr bool PERM = true, AFTER_DRAIN = false; static_assert(ACT == 0 || ACT == 1, "EpiBf16: ACT is 0 (none) or 1 (gelu_pk)");
    bf16_t* O; int ldc; const float* bias; int split_cols; size_t split_stride; float scale0;
    __device__ __forceinline__ void operator()(const f32x4 (&acc)[2][2][4][2], const Unit& u, int wr, int wc, int fr, int fq) const {
        const int row0 = u.pm * BM + wr * 64 + fr; int colt = u.pn * BM; bf16_t* base = O;
        float sc = 1.f; if (split_cols) { const int t = colt / split_cols; base += (size_t)t * split_stride; colt -= t * split_cols; if (t == 0) sc = scale0; }
        const int col0 = colt + wc * 32 + 8 * fq, bcol0 = u.pn * BM + wc * 32 + 8 * fq;
        f32x4 bv[2][2];
#pragma unroll
        for (int bj = 0; bj < 2; ++bj)
#pragma unroll
            for (int n = 0; n < 2; ++n) bv[bj][n] = bias ? *(const f32x4*)(bias + bcol0 + bj * HALF + 4 * n) : (f32x4){0.f, 0.f, 0.f, 0.f};
#pragma unroll
        for (int ai = 0; ai < 2; ++ai)
#pragma unroll
            for (int m = 0; m < 4; ++m) { bf16_t* rowp = base + (size_t)(row0 + ai * HALF + m * 16) * ldc + col0;
#pragma unroll
                for (int bj = 0; bj < 2; ++bj) { f32x4 v0 = acc[ai][bj][m][0] + bv[bj][0], v1 = acc[ai][bj][m][1] + bv[bj][1];
                    if (ACT == 1) { f32x2 a = gelu_pk((f32x2){v0[0], v0[1]}), b = gelu_pk((f32x2){v0[2], v0[3]}), c = gelu_pk((f32x2){v1[0], v1[1]}), d = gelu_pk((f32x2){v1[2], v1[3]});
                        v0 = (f32x4){a.x, a.y, b.x, b.y}; v1 = (f32x4){c.x, c.y, d.x, d.y}; }
                    v0 = v0 * sc; v1 = v1 * sc; u32x4 w; w.x = cvt_pk_bf16(v0[0], v0[1]); w.y = cvt_pk_bf16(v0[2], v0[3]); w.z = cvt_pk_bf16(v1[0], v1[1]); w.w = cvt_pk_bf16(v1[2], v1[3]);
                    *(u32x4*)(rowp + bj * HALF) = w; } }
    }
};

template <class Epi, class Sched, bool ALIGN_EPI = false, bool SP2 = false>
__device__ __forceinline__ void gemm_phase(PG8_LAS unsigned char* lds, const Gemm g, const Sched& S, const Epi& E) {
    const int tid = threadIdx.x, wid = __builtin_amdgcn_readfirstlane(tid >> 6), lane = tid & 63, wr = wid >> 2, wc = wid & 3, fr = lane & 15, fq = lane >> 4;
    const int K = g.K, nt = K / BK;
    unsigned voffA[2], voffB[2];
#pragma unroll
    for (int i = 0; i < 2; ++i) { int R, C; stage_rc(tid * 16 + i * 8192, R, C); const int Rb = Epi::PERM ? ((R & ~31) + perm32(R & 31)) : R;
        voffA[i] = (unsigned)(R * K + C) * 2u; voffB[i] = (unsigned)(Rb * K + C) * 2u; }
    const size_t kstep = (size_t)(BK * 2);
    const size_t hstep = (size_t)HALF * K * 2;
    const size_t tstep = 2 * hstep;
    const unsigned ldsw = (unsigned)wid * 1024u;
    const int aoff = lds_byte(wr * 64 + fr, fq * 8), boff = lds_byte(wc * 32 + fr, fq * 8);
#define PG8_SA(b, h) (((b) * 2 + (h)) * HTB)
#define PG8_SB(b, h) ((4 + (b) * 2 + (h)) * HTB)
#define PG8_STAGE(bufoff, gbase, voff) do { _Pragma("unroll") for (int _i = 0; _i < 2; ++_i) \
        __builtin_amdgcn_global_load_lds((const unsigned*)((const char*)(gbase) + (voff)[_i]), (PG8_LAS unsigned*)(lds + (bufoff) + ldsw + _i * 8192), 16, 0, 0); } while (0)
#define PG8_LDA(dst, b, h) do { _Pragma("unroll") for (int m = 0; m < 4; ++m) _Pragma("unroll") for (int k = 0; k < 2; ++k) dst[m][k] = *(const PG8_LAS bf16x8*)(lds + PG8_SA(b, h) + aoff + m * 2048 + k * 1024); } while (0)
#define PG8_LDB(dst, b, h) do { _Pragma("unroll") for (int n = 0; n < 2; ++n) _Pragma("unroll") for (int k = 0; k < 2; ++k) dst[n][k] = *(const PG8_LAS bf16x8*)(lds + PG8_SB(b, h) + boff + n * 2048 + k * 1024); } while (0)
#define PG8_MMA(ai, bj, At, Bt) do { __builtin_amdgcn_s_setprio(1); _Pragma("unroll") for (int m = 0; m < 4; ++m) _Pragma("unroll") for (int n = 0; n < 2; ++n) _Pragma("unroll") for (int k = 0; k < 2; ++k) \
        acc[ai][bj][m][n] = __builtin_amdgcn_mfma_f32_16x16x32_bf16(Bt[n][k], At[m][k], acc[ai][bj][m][n], 0, 0, 0); __builtin_amdgcn_s_setprio(0); } while (0)
#define PG8_WAIT_V(n) asm volatile("s_waitcnt vmcnt(" #n ")" ::: "memory")
#define PG8_WAIT_L(n) asm volatile("s_waitcnt lgkmcnt(" #n ")" ::: "memory")
#define PG8_BAR __builtin_amdgcn_s_barrier()
#define PG8_SCHED __builtin_amdgcn_sched_barrier(0)
    Unit cur, nxt; int ui = 0;
    if (!S.next(0, cur)) return;
    f32x4 acc[2][2][4][2];
#pragma unroll
    for (int a = 0; a < 2; ++a)
#pragma unroll
        for (int b = 0; b < 2; ++b)
#pragma unroll
            for (int m = 0; m < 4; ++m)
#pragma unroll
                for (int n = 0; n < 2; ++n) acc[a][b][m][n] = (f32x4){0.f, 0.f, 0.f, 0.f};
    bf16x8 At[4][2], B0[2][2], B1[2][2];
    const char* cA = (const char*)g.A + (size_t)cur.pm * tstep; const char* cB = (const char*)g.Bt + (size_t)cur.pn * tstep;
    S.a_ready(cur);
    if constexpr (SP2) {
        PG8_STAGE(PG8_SB(0, 0), cB, voffB); PG8_STAGE(PG8_SB(0, 1), cB + hstep, voffB); PG8_STAGE(PG8_SA(0, 0), cA, voffA); PG8_STAGE(PG8_SA(0, 1), cA + hstep, voffA);
        if (wr == 1) PG8_BAR;
        PG8_WAIT_V(2); PG8_BAR;
        PG8_STAGE(PG8_SB(1, 0), cB + kstep, voffB); PG8_STAGE(PG8_SA(1, 0), cA + kstep, voffA); PG8_STAGE(PG8_SB(1, 1), cB + hstep + kstep, voffB);
        PG8_WAIT_V(6); PG8_BAR;
    } else {
        PG8_STAGE(PG8_SB(0, 0), cB, voffB); PG8_STAGE(PG8_SA(0, 0), cA, voffA); PG8_STAGE(PG8_SB(0, 1), cB + hstep, voffB); PG8_STAGE(PG8_SA(0, 1), cA + hstep, voffA);
        if (wr == 1) PG8_BAR;
        PG8_WAIT_V(4); PG8_BAR;
        PG8_STAGE(PG8_SB(1, 0), cB + kstep, voffB); PG8_STAGE(PG8_SA(1, 0), cA + kstep, voffA); PG8_STAGE(PG8_SB(1, 1), cB + hstep + kstep, voffB);
        PG8_WAIT_V(6); PG8_BAR;
    }
    for (;;) {
        const bool has_next = S.next(ui + 1, nxt);
        const char* nA = has_next ? (const char*)g.A + (size_t)nxt.pm * tstep : cA; const char* nB = has_next ? (const char*)g.Bt + (size_t)nxt.pn * tstep : cB;
        for (int t = 0; t < nt; t += 2) {
            const bool last = (t == nt - 2);
            const char* a1 = cA + (size_t)(t + 1) * kstep;
            const char* a2 = last ? nA : cA + (size_t)(t + 2) * kstep; const char* b2 = last ? nB : cB + (size_t)(t + 2) * kstep;
            const char* a3 = a2 + kstep; const char* b3 = b2 + kstep;
            if (last && has_next) S.a_ready(nxt);
            if constexpr (SP2) {
            PG8_LDB(B0, 0, 0); PG8_LDB(B1, 0, 1); PG8_SCHED; PG8_LDA(At, 0, 0); PG8_STAGE(PG8_SA(1, 1), a1 + hstep, voffA);
            PG8_WAIT_V(8); PG8_WAIT_L(0); PG8_BAR; PG8_MMA(0, 0, At, B0); PG8_MMA(0, 1, At, B1); PG8_BAR; PG8_SCHED;
            PG8_LDA(At, 0, 1); PG8_STAGE(PG8_SB(0, 0), b2, voffB); PG8_STAGE(PG8_SB(0, 1), b2 + hstep, voffB); PG8_STAGE(PG8_SA(0, 0), a2, voffA);
            PG8_WAIT_V(8); PG8_WAIT_L(0); PG8_BAR; PG8_MMA(1, 0, At, B0); PG8_MMA(1, 1, At, B1); PG8_BAR; PG8_SCHED;
            PG8_LDB(B0, 1, 0); PG8_LDB(B1, 1, 1); PG8_SCHED; PG8_LDA(At, 1, 0); PG8_STAGE(PG8_SA(0, 1), a2 + hstep, voffA);
            PG8_WAIT_V(8); PG8_WAIT_L(0); PG8_BAR; PG8_MMA(0, 0, At, B0); PG8_MMA(0, 1, At, B1); PG8_BAR; PG8_SCHED;
            PG8_LDA(At, 1, 1); PG8_STAGE(PG8_SB(1, 0), b3, voffB); PG8_STAGE(PG8_SB(1, 1), b3 + hstep, voffB); PG8_STAGE(PG8_SA(1, 0), a3, voffA);
            PG8_WAIT_V(8); PG8_WAIT_L(0); PG8_BAR; PG8_MMA(1, 0, At, B0); PG8_MMA(1, 1, At, B1); PG8_BAR; PG8_SCHED;
            } else {
            PG8_LDB(B0, 0, 0); PG8_SCHED; PG8_LDA(At, 0, 0); PG8_STAGE(PG8_SA(1, 1), a1 + hstep, voffA);
            PG8_WAIT_L(8); PG8_BAR; PG8_WAIT_L(0); PG8_MMA(0, 0, At, B0); PG8_BAR; PG8_SCHED;
            PG8_LDB(B1, 0, 1); PG8_STAGE(PG8_SB(0, 0), b2, voffB);
            PG8_BAR; PG8_WAIT_L(0); PG8_MMA(0, 1, At, B1); PG8_BAR;
            PG8_LDA(At, 0, 1); PG8_STAGE(PG8_SA(0, 0), a2, voffA);
            PG8_BAR; PG8_WAIT_L(0); PG8_MMA(1, 0, At, B0); PG8_BAR; PG8_SCHED;
            PG8_STAGE(PG8_SB(0, 1), b2 + hstep, voffB);
            PG8_WAIT_V(6); PG8_BAR; PG8_MMA(1, 1, At, B1); PG8_BAR;
            PG8_LDB(B0, 1, 0); PG8_SCHED; PG8_LDA(At, 1, 0); PG8_STAGE(PG8_SA(0, 1), a2 + hstep, voffA);
            PG8_WAIT_L(8); PG8_BAR; PG8_WAIT_L(0); PG8_MMA(0, 0, At, B0); PG8_BAR; PG8_SCHED;
            PG8_LDB(B1, 1, 1); PG8_STAGE(PG8_SB(1, 0), b3, voffB);
            PG8_BAR; PG8_WAIT_L(0); PG8_MMA(0, 1, At, B1); PG8_BAR;
            PG8_LDA(At, 1, 1); PG8_STAGE(PG8_SA(1, 0), a3, voffA);
            PG8_BAR; PG8_WAIT_L(0); PG8_MMA(1, 0, At, B0); PG8_BAR; PG8_SCHED;
            PG8_STAGE(PG8_SB(1, 1), b3 + hstep, voffB);
            PG8_WAIT_V(6); PG8_BAR; PG8_MMA(1, 1, At, B1); PG8_BAR;
            }
        }
        if constexpr (ALIGN_EPI) { if (wr == 0) PG8_BAR; }
        if constexpr (!Epi::AFTER_DRAIN) { E(acc, cur, wr, wc, fr, fq); S.done(cur); }
        if (!has_next) break;
#pragma unroll
        for (int a = 0; a < 2; ++a)
#pragma unroll
            for (int b = 0; b < 2; ++b)
#pragma unroll
                for (int m = 0; m < 4; ++m)
#pragma unroll
                    for (int n = 0; n < 2; ++n) acc[a][b][m][n] = (f32x4){0.f, 0.f, 0.f, 0.f};
        cur = nxt; cA = nA; cB = nB; ++ui;
        if constexpr (ALIGN_EPI) { if (wr == 1) PG8_BAR; }
    }
    PG8_WAIT_V(0);
    if constexpr (!ALIGN_EPI) { if (wr == 0) PG8_BAR; }
    PG8_BAR;
    if constexpr (Epi::AFTER_DRAIN) { E.fused(acc, cur, wr, wc, fr, fq, lds, wid, lane); S.done(cur); }
#undef PG8_SA
#undef PG8_SB
#undef PG8_STAGE
#undef PG8_LDA
#undef PG8_LDB
#undef PG8_MMA
#undef PG8_WAIT_V
#undef PG8_WAIT_L
#undef PG8_BAR
#undef PG8_SCHED
}
}

#define LAS __attribute__((address_space(3)))
typedef unsigned short bf16;
typedef pg8::f32x4 f32x4;
typedef pg8::bf16x8 bf16x8;
typedef pg8::u32x4 u32x4;
typedef unsigned u32x2 __attribute__((ext_vector_type(2)));

constexpr int DM = 2048, TT = 4096, NB = 2, LC = 256;
constexpr int NLAT = NB * TT, NCTX = NB * LC, MROWS = NLAT + NCTX;
constexpr int INC = 6656, DFF = 5632, NMODV = 12288;
constexpr int C_Q = 0, C_FF = 1024, C_FB = 2048, C_I = 3072, C_G = 4096, C_AQ = 5120, C_AK = 6144, C_AV = 6400;
constexpr float RMS_EPS = 1e-6f;
constexpr int NTHR = 512, NWAVES = 8;
constexpr int NSCAN = 64;

constexpr size_t MiB = 1u << 20;
constexpr size_t WS_MOD = 0, WS_ROPE = 256 * 1024;
constexpr size_t WS_WOUT = 1 * MiB, WS_WGU = 9 * MiB, WS_WDN = 53 * MiB, WS_WIN = 75 * MiB;
constexpr size_t WS_REC0 = 75 * MiB;
constexpr size_t WS_H = 101 * MiB, WS_P = 135 * MiB, WS_ACT = WS_P, WS_OF = 246 * MiB, WS_OB = 278 * MiB, WS_MIX = 310 * MiB, WS_END = 352 * MiB;
constexpr int LDS_BYTES = 143360;

__device__ __forceinline__ float bf2f(unsigned short u) { return __uint_as_float(((unsigned)u) << 16); }
typedef float f32x2_t __attribute__((ext_vector_type(2)));
typedef __bf16 bf16x2_t __attribute__((ext_vector_type(2)));
__device__ __forceinline__ unsigned pk2(float lo, float hi) { const f32x2_t v = {lo, hi}; const bf16x2_t b = __builtin_convertvector(v, bf16x2_t); return __builtin_bit_cast(unsigned, b); }
__device__ __forceinline__ unsigned short f2bf(float x) { const __bf16 b = (__bf16)x; return __builtin_bit_cast(unsigned short, b); }
__device__ __forceinline__ float wave_sum(float v) {
#pragma unroll
    for (int o = 1; o < 64; o <<= 1) v += __shfl_xor(v, o);
    return v;
}
__device__ __forceinline__ float sigmoidf_(float x) { return 1.f / (1.f + __expf(-x)); }
__device__ __forceinline__ float siluf_(float x) { return x / (1.f + __expf(-x)); }

__device__ __forceinline__ void transpose_item(const float* W, int K, int N, bf16* WT, int k0, int n0, int drow, LAS float* scr, int lane) {
    const int kq = lane >> 4, nx = lane & 15;
#pragma unroll 1
    for (int hb = 0; hb < 2; ++hb) {
        f32x4 v[8];
#pragma unroll
        for (int i = 0; i < 8; ++i) v[i] = *(const f32x4*)(W + (size_t)(k0 + 32 * hb + 4 * i + kq) * N + n0 + 4 * nx);
#pragma unroll
        for (int i = 0; i < 8; ++i) { LAS float* d = scr + (4 * nx) * 65 + 32 * hb + 4 * i + kq; d[0] = v[i].x; d[65] = v[i].y; d[130] = v[i].z; d[195] = v[i].w; }
    }
    asm volatile("s_waitcnt lgkmcnt(0)" ::: "memory");
    const int c = lane & 7;
#pragma unroll
    for (int j = 0; j < 8; ++j) { const int n = (lane >> 3) + 8 * j; const LAS float* s = scr + n * 65 + 8 * c;
        u32x4 o; o.x = pk2(s[0], s[1]); o.y = pk2(s[2], s[3]); o.z = pk2(s[4], s[5]); o.w = pk2(s[6], s[7]);
        *(u32x4*)(WT + (size_t)(drow + n) * K + k0 + 8 * c) = o; }
    asm volatile("s_waitcnt lgkmcnt(0)" ::: "memory");
}

__device__ __forceinline__ void convert_weights(int mask, const float* const* in, unsigned char* ws, LAS unsigned char* lds, int w, int nw, int lane, int wave) {
    LAS float* scr = (LAS float*)(lds + wave * 16640);
    const int cnt0 = (mask & 1) ? (DM / 64) * (INC / 64) : 0, cnt1 = (mask & 2) ? (DM / 64) * (DM / 64) : 0, cnt2 = (mask & 4) ? (DFF / 64) * (DM / 64) : 0, cnt3 = (mask & 8) ? (DM / 64) * (2 * DFF / 64) : 0;
#pragma unroll 1
    for (int it = w; it < cnt0 + cnt1 + cnt2 + cnt3; it += nw) {
        int r = it, m = 0;
        if (r >= cnt0) { r -= cnt0; m = 1; if (r >= cnt1) { r -= cnt1; m = 2; if (r >= cnt2) { r -= cnt2; m = 3; } } }
        const float* W = m == 0 ? in[8] : (m == 1 ? in[14] : (m == 2 ? in[16] : in[15]));
        const int K = m == 2 ? DFF : DM, N = m == 0 ? INC : (m == 3 ? 2 * DFF : DM);
        bf16* WT = (bf16*)(ws + (m == 0 ? WS_WIN : (m == 1 ? WS_WOUT : (m == 2 ? WS_WDN : WS_WGU))));
        const int nblk = N / 64, kb = r / nblk, nb = r % nblk, n0 = 64 * nb;
        int drow = n0;
        if (m == 3) { const int half = n0 / DFF, j = n0 % DFF; drow = 256 * (j / 128) + 128 * half + (j % 128); }
        transpose_item(W, K, N, WT, 64 * kb, n0, drow, scr, lane);
    }
}

__device__ __forceinline__ void mod_item(int item, const float* c, const float* c_ctx, const float* w_mod, const float* b_mod, float* MOD, LAS float* L, int tid) {
    LAS float* sv = L;
    LAS float* red = L + 6144;
    for (int i = tid; i < 3 * DM; i += NTHR) { const int v = i / DM, k = i % DM; const float x = v < 2 ? c[v * DM + k] : c_ctx[k]; sv[i] = siluf_(x); }
    __syncthreads();
    const int cl = tid & 15, rl = tid >> 4, col = item * 64 + cl * 4;
    f32x4 a0 = {0.f, 0.f, 0.f, 0.f}, a1 = a0, a2 = a0;
#pragma unroll 8
    for (int k = rl; k < DM; k += 32) { const f32x4 w = *(const f32x4*)(w_mod + (size_t)k * NMODV + col); a0 += w * sv[k]; a1 += w * sv[DM + k]; a2 += w * sv[2 * DM + k]; }
    LAS float* r = red + tid * 12;
    r[0] = a0.x; r[1] = a0.y; r[2] = a0.z; r[3] = a0.w; r[4] = a1.x; r[5] = a1.y; r[6] = a1.z; r[7] = a1.w; r[8] = a2.x; r[9] = a2.y; r[10] = a2.z; r[11] = a2.w;
    __syncthreads();
    if (tid < 16 * 12) { const int cl2 = tid / 12, e = tid % 12; float s = 0.f;
        for (int q = 0; q < 32; ++q) s += red[(q * 16 + cl2) * 12 + e];
        const int v = e >> 2, cc = item * 64 + cl2 * 4 + (e & 3); MOD[v * NMODV + cc] = s + b_mod[cc]; }
    __syncthreads();
}

__device__ __forceinline__ void phase0(const float* const* in, unsigned char* ws, LAS unsigned char* lds, int tid, int lane, int wave) {
    const int blk = blockIdx.x, G = gridDim.x;
    float* MOD = (float*)(ws + WS_MOD);
    __syncthreads();
    for (int item = blk; item < NMODV / 64; item += G) mod_item(item, in[1], in[3], in[4], in[5], MOD, (LAS float*)lds, tid);
    if (blk == G - 1) {
        float* RC = (float*)(ws + WS_ROPE); float* RS = RC + 2048;
        for (int i = tid; i < 2048; i += NTHR) { const int pos = i >> 5, f = i & 31; const double inv = pow(10000.0, -(double)f / 32.0); const float ang = (float)pos * (float)inv;
            RC[i] = (float)cos((double)ang); RS[i] = (float)sin((double)ang); }
    }
    convert_weights(G > NSCAN ? 1 : 9, in, ws, lds, blk * NWAVES + wave, G * NWAVES, lane, wave);
}

__device__ __forceinline__ void norm_mod_row(const float* src, const float* gamma, const float* shift, const float* scale, bf16* dst, int lane) {
    const f32x4* xr = (const f32x4*)src + lane;
    f32x4 v[8]; float ss = 0.f;
#pragma unroll
    for (int j = 0; j < 8; ++j) { v[j] = xr[64 * j]; ss += (v[j].x * v[j].x + v[j].y * v[j].y) + (v[j].z * v[j].z + v[j].w * v[j].w); }
    const float rstd = rsqrtf(wave_sum(ss) * (1.f / DM) + RMS_EPS);
    u32x2* o = (u32x2*)dst + lane;
#pragma unroll
    for (int j = 0; j < 8; ++j) {
        const f32x4 g = ((const f32x4*)gamma)[lane + 64 * j], sh = ((const f32x4*)shift)[lane + 64 * j], sc = ((const f32x4*)scale)[lane + 64 * j];
        const f32x4 y = v[j] * rstd * g; const f32x4 h = y * (sc + 1.f) + sh;
        u32x2 w; w.x = pk2(h.x, h.y); w.y = pk2(h.z, h.w); o[64 * j] = w;
    }
}

struct EpiResGate {
    static constexpr bool PERM = false, AFTER_DRAIN = false;
    const float* base; float* out; const float* gate;
    __device__ __forceinline__ void operator()(const f32x4 (&acc)[2][2][4][2], const pg8::Unit& u, int wr, int wc, int fr, int fq) const {
        const int row0 = u.pm * 256 + wr * 64 + fr, col0 = u.pn * 256 + wc * 32 + 4 * fq;
        const float* gv = gate + (size_t)(u.pm / 16) * NMODV;
#pragma unroll
        for (int bj = 0; bj < 2; ++bj)
#pragma unroll
            for (int n = 0; n < 2; ++n) { const int col = col0 + bj * 128 + n * 16; const f32x4 g = *(const f32x4*)(gv + col);
#pragma unroll
                for (int ai = 0; ai < 2; ++ai)
#pragma unroll
                    for (int m = 0; m < 4; ++m) { const size_t off = (size_t)(row0 + ai * 128 + m * 16) * DM + col;
                        const f32x4 b = *(const f32x4*)(base + off); *(f32x4*)(out + off) = b + g * acc[ai][bj][m][n]; } }
    }
};
struct EpiSwiGLU {
    static constexpr bool PERM = true, AFTER_DRAIN = false;
    bf16* O;
    __device__ __forceinline__ void operator()(const f32x4 (&acc)[2][2][4][2], const pg8::Unit& u, int wr, int wc, int fr, int fq) const {
        const int row0 = u.pm * 256 + wr * 64 + fr, col0 = u.pn * 128 + wc * 32 + 8 * fq;
#pragma unroll
        for (int ai = 0; ai < 2; ++ai)
#pragma unroll
            for (int m = 0; m < 4; ++m) {
                const f32x4 g0 = acc[ai][0][m][0], g1 = acc[ai][0][m][1], u0 = acc[ai][1][m][0], u1 = acc[ai][1][m][1];
                u32x4 w; w.x = pk2(siluf_(g0.x) * u0.x, siluf_(g0.y) * u0.y); w.y = pk2(siluf_(g0.z) * u0.z, siluf_(g0.w) * u0.w);
                w.z = pk2(siluf_(g1.x) * u1.x, siluf_(g1.y) * u1.y); w.w = pk2(siluf_(g1.z) * u1.z, siluf_(g1.w) * u1.w);
                *(u32x4*)(O + (size_t)(row0 + ai * 128 + m * 16) * DFF + col0) = w; }
    }
};


#define MFMA16(a, b, c) __builtin_amdgcn_mfma_f32_16x16x32_bf16((a), (b), (c), 0, 0, 0)
constexpr int SQ_STR = 136;

constexpr int REC_BYTES = 27648, R_QD = 0, R_KRT = 8704, R_VT = 16896, R_SC = 25088, R_DK = 27136;
constexpr int NCHUNK = 136, NITEMS_A = 32 * NCHUNK;
__device__ __forceinline__ unsigned char* rec_ptr(unsigned char* ws, float* dout, int b, int h, int dir, int n) {
    unsigned char* base = dir ? (unsigned char*)dout : ws + WS_REC0; return base + (size_t)((b * 8 + h) * NCHUNK + n) * REC_BYTES; }
__device__ __forceinline__ size_t scan_row(int b, int dir, int n, int s) {
    if (n < 8) { const int p = 32 * n + s; return (size_t)(NLAT + b * LC + (dir ? (LC - 1 - p) : p)); }
    const int p = 32 * (n - 8) + s; return (size_t)(b * TT + (dir ? (TT - 1 - p) : p)); }

__device__ __forceinline__ void scan_prep(const bf16* P, const float* hg_lb, unsigned char* ws, float* dout, LAS unsigned char* lds, int tid, int lane, int wave) {
    LAS bf16* QD = (LAS bf16*)(lds); LAS bf16* KI = (LAS bf16*)(lds + 8704); LAS float* TOT = (LAS float*)(lds + 17408);
    const int k = tid & 127, sg = tid >> 7, fr = lane & 15, quad = lane >> 4, G = gridDim.x;
    const int kp = (k & ~31) | (8 * ((k >> 2) & 3) + 4 * ((k >> 4) & 1) + (k & 3));
    unsigned short rq[8], rf[8], rv[8];
    int it = blockIdx.x;
    if (it < NITEMS_A) { const int n = it % NCHUNK, bhd = it / NCHUNK, dir = bhd & 1, h = (bhd >> 1) & 7, b = bhd >> 4;
#pragma unroll
        for (int j = 0; j < 8; ++j) { const bf16* pr = P + scan_row(b, dir, n, 8 * sg + j) * INC + h * 128 + k; rq[j] = pr[C_Q]; rf[j] = pr[dir ? C_FB : C_FF]; rv[j] = pr[C_I]; } }
    __syncthreads();
    for (; it < NITEMS_A; it += G) {
        const int n = it % NCHUNK, bhd = it / NCHUNK, dir = bhd & 1, h = (bhd >> 1) & 7, b = bhd >> 4;
        unsigned char* rec = rec_ptr(ws, dout, b, h, dir, n);
        const float lb = 1.f / (1.f + __expf(hg_lb[2048 + dir * 1024 + h * 128 + k] - hg_lb[dir * 1024 + h * 128 + k]));
        float lf[8], kk[8], qv[8]; unsigned short vv[8]; float cs = 0.f;
#pragma unroll
        for (int j = 0; j < 8; ++j) { const float fp = bf2f(rf[j]); const float ef = __expf(-fp), sgm = __builtin_amdgcn_rcpf(1.f + ef);
            const float f = lb + (1.f - lb) * sgm; kk[j] = (1.f - lb) * ef * sgm;
            cs += __logf(f); lf[j] = cs; const float qp = bf2f(rq[j]); qv[j] = qp * __builtin_amdgcn_rcpf(1.f + __expf(-qp)); vv[j] = rv[j]; }
        { const int it2 = it + G;
          if (it2 < NITEMS_A) { const int n2 = it2 % NCHUNK, bhd2 = it2 / NCHUNK, dir2 = bhd2 & 1, h2 = (bhd2 >> 1) & 7, b2 = bhd2 >> 4;
#pragma unroll
            for (int j = 0; j < 8; ++j) { const bf16* pr = P + scan_row(b2, dir2, n2, 8 * sg + j) * INC + h2 * 128 + k; rq[j] = pr[C_Q]; rf[j] = pr[dir2 ? C_FB : C_FF]; rv[j] = pr[C_I]; } } }
        TOT[sg * 128 + k] = cs;
        __syncthreads();
        const float t0 = TOT[k], t1 = TOT[128 + k], t2 = TOT[256 + k], t3 = TOT[384 + k];
        const float off = sg == 0 ? 0.f : (sg == 1 ? t0 : (sg == 2 ? t0 + t1 : t0 + t1 + t2)), blast = (t0 + t1) + (t2 + t3);
        unsigned krp[4];
        const float eb = __expf(blast);
#pragma unroll
        for (int j = 0; j < 8; j += 2) {
            const float b0 = off + lf[j], b1 = off + lf[j + 1];
            const float e0 = __expf(b0), e1 = __expf(b1), i0 = __builtin_amdgcn_rcpf(e0), i1 = __builtin_amdgcn_rcpf(e1);
            if (n >= 8) {
                const unsigned short q0 = f2bf(qv[j] * e0), q1 = f2bf(qv[j + 1] * e1);
                QD[(8 * sg + j) * SQ_STR + kp] = q0; QD[(8 * sg + j + 1) * SQ_STR + kp] = q1;
                ((bf16*)(rec + R_QD))[(8 * sg + j) * SQ_STR + kp] = q0; ((bf16*)(rec + R_QD))[(8 * sg + j + 1) * SQ_STR + kp] = q1;
                KI[(8 * sg + j) * SQ_STR + kp] = f2bf(kk[j] * i0); KI[(8 * sg + j + 1) * SQ_STR + kp] = f2bf(kk[j + 1] * i1);
            }
            krp[j >> 1] = pk2(kk[j] * (eb * i0), kk[j + 1] * (eb * i1));
        }
        *(u32x4*)(rec + R_KRT + k * 64 + ((sg ^ ((k >> 2) & 3)) * 16)) = (u32x4){krp[0], krp[1], krp[2], krp[3]};
        *(u32x4*)(rec + R_VT + k * 64 + ((sg ^ ((k >> 2) & 3)) * 16)) = (u32x4){(unsigned)vv[0] | ((unsigned)vv[1] << 16), (unsigned)vv[2] | ((unsigned)vv[3] << 16), (unsigned)vv[4] | ((unsigned)vv[5] << 16), (unsigned)vv[6] | ((unsigned)vv[7] << 16)};
        if (sg == 0) ((float*)(rec + R_DK))[k] = eb;
        __syncthreads();
        if (n >= 8 && wave < 4) {
            const int ct = wave >> 1, st = wave & 1; f32x4 a = {0.f, 0.f, 0.f, 0.f};
#pragma unroll
            for (int ks = 0; ks < 4; ++ks) { const bf16x8 af = *(const LAS bf16x8*)(QD + (16 * ct + fr) * SQ_STR + 32 * ks + 8 * quad); const bf16x8 bfr = *(const LAS bf16x8*)(KI + (16 * st + fr) * SQ_STR + 32 * ks + 8 * quad);
                a = MFMA16(af, bfr, a); }
#pragma unroll
            for (int r = 0; r < 4; ++r) { const int c = 16 * ct + 4 * quad + r, s2 = 16 * st + fr; ((bf16*)(rec + R_SC))[c * 32 + ((((s2 >> 3) ^ ((c >> 2) & 3))) << 3) + (s2 & 7)] = f2bf(s2 <= c ? a[r] : 0.f); }
        }
    }
    __syncthreads();
}

__device__ __forceinline__ void scan_apply(int item, unsigned char* ws, float* dout, float* OF, float* OB, LAS unsigned char* lds, int tid, int lane, int wave) {
    const int vh = item & 1, dir = (item >> 1) & 1, h = (item >> 2) & 7, b = item >> 5, fr = lane & 15, quad = lane >> 4;
    float* OUT = dir ? OB : OF;
    const unsigned char* rec0 = rec_ptr(ws, dout, b, h, dir, 0);
    const int swz = quad ^ ((fr >> 2) & 3);
    const bool active = wave < 4;
    const int vtile = 4 * vh + (wave & 3);
    f32x4 Sacc[8];
#pragma unroll
    for (int kt = 0; kt < 8; ++kt) Sacc[kt] = (f32x4){0.f, 0.f, 0.f, 0.f};
    constexpr int NSLOT = 5;
#define SA_STAGE(chunk) do { const int _c = (chunk) < NCHUNK ? (chunk) : NCHUNK - 1; const unsigned char* _g = rec0 + (size_t)_c * REC_BYTES + lane * 16; LAS unsigned char* _l = lds + ((chunk) % NSLOT) * REC_BYTES; \
        _Pragma("unroll") for (int _i = 0; _i < 7; ++_i) { const int _p = (wave - 4) * 7 + _i < 27 ? (wave - 4) * 7 + _i : 26; \
            __builtin_amdgcn_global_load_lds((const unsigned*)(_g + _p * 1024), (LAS unsigned*)(_l + _p * 1024), 16, 0, 0); } } while (0)
    __syncthreads();
    if (!active) { SA_STAGE(0); SA_STAGE(1); SA_STAGE(2); SA_STAGE(3); }
    const long rstep = dir ? -1024 : 1024;
#define SA_HEAD(n) do { if (!active) asm volatile("s_waitcnt vmcnt(21)" ::: "memory");     \
        __builtin_amdgcn_s_barrier(); asm volatile("" ::: "memory"); \
        if (!active) SA_STAGE((n) + 4);                                } while (0)
    for (int n = 0; n < 8; ++n) {
        SA_HEAD(n);
        if (active) {
            const LAS unsigned char* slot = lds + (n % NSLOT) * REC_BYTES;
            const bf16x8 vfr = *(const LAS bf16x8*)(slot + R_VT + (16 * vtile + fr) * 64 + swz * 16);
#pragma unroll
            for (int kt = 0; kt < 8; ++kt) {
                const f32x4 d = *(const LAS f32x4*)(slot + R_DK + (16 * kt + 4 * quad) * 4);
                const bf16x8 af = *(const LAS bf16x8*)(slot + R_KRT + (16 * kt + fr) * 64 + swz * 16);
                Sacc[kt] = MFMA16(af, vfr, Sacc[kt] * d);
            }
        }
    }
    for (int n = 8; n < NCHUNK; ++n) {
        SA_HEAD(n);
        if (active) {
            const LAS unsigned char* slot = lds + (n % NSLOT) * REC_BYTES;
            const bf16x8 vfr = *(const LAS bf16x8*)(slot + R_VT + (16 * vtile + fr) * 64 + swz * 16);
            bf16x8 sb[4];
#pragma unroll
            for (int ks = 0; ks < 4; ++ks) sb[ks] = __builtin_bit_cast(bf16x8, (u32x4){pk2(Sacc[2 * ks].x, Sacc[2 * ks].y), pk2(Sacc[2 * ks].z, Sacc[2 * ks].w), pk2(Sacc[2 * ks + 1].x, Sacc[2 * ks + 1].y), pk2(Sacc[2 * ks + 1].z, Sacc[2 * ks + 1].w)});
            float* op = OUT + scan_row(b, dir, n, 4 * quad) * 1024 + h * 128 + 16 * vtile + fr;
            f32x4 o0 = {0.f, 0.f, 0.f, 0.f}, o1 = o0;
            { const bf16x8 a0 = *(const LAS bf16x8*)(slot + R_SC + (fr) * 64 + swz * 16), a1 = *(const LAS bf16x8*)(slot + R_SC + (16 + fr) * 64 + swz * 16); o0 = MFMA16(a0, vfr, o0); o1 = MFMA16(a1, vfr, o1); }
#pragma unroll
            for (int ks = 0; ks < 4; ++ks) {
                const bf16x8 a0 = *(const LAS bf16x8*)(slot + R_QD + (fr) * (SQ_STR * 2) + (32 * ks + 8 * quad) * 2), a1 = *(const LAS bf16x8*)(slot + R_QD + (16 + fr) * (SQ_STR * 2) + (32 * ks + 8 * quad) * 2);
                o0 = MFMA16(a0, sb[ks], o0); o1 = MFMA16(a1, sb[ks], o1);
#pragma unroll
                for (int kk2 = 0; kk2 < 2; ++kk2) { const int kt = 2 * ks + kk2;
                    const f32x4 d = *(const LAS f32x4*)(slot + R_DK + (16 * kt + 4 * quad) * 4);
                    const bf16x8 af = *(const LAS bf16x8*)(slot + R_KRT + (16 * kt + fr) * 64 + swz * 16);
                    Sacc[kt] = MFMA16(af, vfr, Sacc[kt] * d); }
            }
#pragma unroll
            for (int r = 0; r < 4; ++r) { op[r * rstep] = o0[r]; op[(16 + r) * rstep] = o1[r]; }
        }
    }
#undef SA_HEAD
    asm volatile("s_waitcnt vmcnt(0)" ::: "memory");
    __syncthreads();
#undef SA_STAGE
}

constexpr int AQ_STR = 136, AV_STR = 72;
constexpr int AT_OFF_Q = 0, AT_OFF_K = 256 * AQ_STR * 2, AT_OFF_VT = AT_OFF_K + 64 * AQ_STR * 2;
__device__ __forceinline__ void rows64_load(const bf16* src0, size_t row_stride, int tid, u32x2 (&raw)[4]) {
    const bf16* src = src0 + (size_t)(tid >> 3) * row_stride + (tid & 7) * 4;
#pragma unroll
    for (int g = 0; g < 4; ++g) raw[g] = *(const u32x2*)(src + 32 * g);
}
__device__ __forceinline__ void rows64_proc(const u32x2 (&raw)[4], int pos0, bool rope, const float* gamma, const float* RC, const float* RS, LAS bf16* dst, int tid, float mul) {
    const int rr = tid >> 3, sub = tid & 7;
    float y[4][4]; float ss = 0.f;
#pragma unroll
    for (int g = 0; g < 4; ++g) { const u32x2 w = raw[g];
        y[g][0] = __uint_as_float(w.x << 16); y[g][1] = __uint_as_float(w.x & 0xffff0000u); y[g][2] = __uint_as_float(w.y << 16); y[g][3] = __uint_as_float(w.y & 0xffff0000u);
        ss += (y[g][0] * y[g][0] + y[g][1] * y[g][1]) + (y[g][2] * y[g][2] + y[g][3] * y[g][3]); }
    ss += __shfl_xor(ss, 1); ss += __shfl_xor(ss, 2); ss += __shfl_xor(ss, 4);
    const float rstd = rsqrtf(ss * (1.f / 128.f) + RMS_EPS) * mul;
#pragma unroll
    for (int g = 0; g < 4; ++g) { const f32x4 gm = *(const f32x4*)(gamma + sub * 4 + 32 * g);
        y[g][0] *= rstd * gm.x; y[g][1] *= rstd * gm.y; y[g][2] *= rstd * gm.z; y[g][3] *= rstd * gm.w; }
    if (rope) {
        const int pos = pos0 + rr, prow = pos >> 6, pcol = pos & 63;
        const f32x4 cr = *(const f32x4*)(RC + prow * 32 + sub * 4), sr = *(const f32x4*)(RS + prow * 32 + sub * 4), cc = *(const f32x4*)(RC + pcol * 32 + sub * 4), sc = *(const f32x4*)(RS + pcol * 32 + sub * 4);
#pragma unroll
        for (int e = 0; e < 4; ++e) { const float a = y[0][e], bb = y[1][e]; y[0][e] = a * cr[e] - bb * sr[e]; y[1][e] = a * sr[e] + bb * cr[e];
            const float a2 = y[2][e], b2 = y[3][e]; y[2][e] = a2 * cc[e] - b2 * sc[e]; y[3][e] = a2 * sc[e] + b2 * cc[e]; }
    }
#pragma unroll
    for (int g = 0; g < 4; ++g) *(LAS u32x2*)(dst + rr * AQ_STR + sub * 4 + 32 * g) = (u32x2){pk2(y[g][0], y[g][1]), pk2(y[g][2], y[g][3])};
}
__device__ __forceinline__ void vt64_load(const bf16* src0, size_t row_stride, int tid, u32x2 (&x)[4]) {
    const int kg = tid & 15, dg = tid >> 4;
#pragma unroll
    for (int i = 0; i < 4; ++i) x[i] = *(const u32x2*)(src0 + (size_t)(4 * kg + i) * row_stride + 4 * dg);
}
__device__ __forceinline__ void vt64_store(const u32x2 (&x)[4], LAS bf16* VT, int tid) {
    const int kg = tid & 15, dg = tid >> 4;
    const unsigned e0[4] = {x[0].x & 0xffffu, x[1].x & 0xffffu, x[2].x & 0xffffu, x[3].x & 0xffffu};
    const unsigned e1[4] = {x[0].x >> 16, x[1].x >> 16, x[2].x >> 16, x[3].x >> 16};
    const unsigned e2[4] = {x[0].y & 0xffffu, x[1].y & 0xffffu, x[2].y & 0xffffu, x[3].y & 0xffffu};
    const unsigned e3[4] = {x[0].y >> 16, x[1].y >> 16, x[2].y >> 16, x[3].y >> 16};
    *(LAS u32x2*)(VT + (4 * dg + 0) * AV_STR + 4 * kg) = (u32x2){e0[0] | (e0[1] << 16), e0[2] | (e0[3] << 16)};
    *(LAS u32x2*)(VT + (4 * dg + 1) * AV_STR + 4 * kg) = (u32x2){e1[0] | (e1[1] << 16), e1[2] | (e1[3] << 16)};
    *(LAS u32x2*)(VT + (4 * dg + 2) * AV_STR + 4 * kg) = (u32x2){e2[0] | (e2[1] << 16), e2[2] | (e2[3] << 16)};
    *(LAS u32x2*)(VT + (4 * dg + 3) * AV_STR + 4 * kg) = (u32x2){e3[0] | (e3[1] << 16), e3[2] | (e3[3] << 16)};
}

__device__ __forceinline__ void attn_unit(int unit, const bf16* P, const float* q_g, const float* k_g, const float* sink, const float* RC, const float* RS, bf16* MIX,
                                          LAS unsigned char* lds, int tid, int lane, int wave) {
    const int b = unit >> 7, kvh = (unit >> 6) & 1, qb = unit & 63, q0 = qb * 64;
    LAS bf16* QS = (LAS bf16*)(lds + AT_OFF_Q); LAS bf16* KS = (LAS bf16*)(lds + AT_OFF_K); LAS bf16* VT = (LAS bf16*)(lds + AT_OFF_VT);
    const int fr = lane & 15, quad = lane >> 4, g = wave >> 1, th = wave & 1;
    const float LOG2E = 1.4426950408889634f, cscale = 0.08838834764831845f * LOG2E;
    __syncthreads();
    auto tile_s0 = [&](int ti) -> int { return ti < 4 ? 64 * ti : q0 - 128 + 64 * (ti - 4); };
    auto tile_row0 = [&](int ti) -> size_t { const int s0 = tile_s0(ti); return ti < 4 ? (size_t)(NLAT + b * LC + s0) : (size_t)(b * TT + s0); };
    auto next_tile = [&](int ti) -> int { ++ti; while (ti < 9 && ti >= 4 && (tile_s0(ti) < 0 || tile_s0(ti) >= TT)) ++ti; return ti; };
    u32x2 kraw[4], vraw[4];
#pragma unroll 1
    for (int gp = 0; gp < 2; ++gp) { u32x2 qraw[2][4];
#pragma unroll
      for (int gg = 0; gg < 2; ++gg) rows64_load(P + (size_t)(b * TT + q0) * INC + C_AQ + (kvh * 4 + 2 * gp + gg) * 128, INC, tid, qraw[gg]);
      if (gp == 1) { rows64_load(P + tile_row0(0) * INC + C_AK + kvh * 128, INC, tid, kraw); vt64_load(P + tile_row0(0) * INC + C_AV + kvh * 128, INC, tid, vraw); }
#pragma unroll
      for (int gg = 0; gg < 2; ++gg) rows64_proc(qraw[gg], q0, true, q_g, RC, RS, QS + (2 * gp + gg) * 64 * AQ_STR, tid, cscale); }
    __syncthreads();
    float m[2], l[2];
    m[0] = m[1] = sink[kvh * 4 + g] * LOG2E; l[0] = l[1] = 1.f;
    f32x4 oacc[8][2];
#pragma unroll
    for (int dt = 0; dt < 8; ++dt) { oacc[dt][0] = (f32x4){0.f, 0.f, 0.f, 0.f}; oacc[dt][1] = (f32x4){0.f, 0.f, 0.f, 0.f}; }
#pragma unroll 1
    for (int ti = 0; ti < 9; ) {
        const bool isctx = ti < 4; const int s0 = tile_s0(ti);
        __syncthreads();
        rows64_proc(kraw, s0, !isctx, k_g, RC, RS, KS, tid, 1.f);
        vt64_store(vraw, VT, tid);
        __syncthreads();
        const int tn = next_tile(ti);
        if (tn < 9) { rows64_load(P + tile_row0(tn) * INC + C_AK + kvh * 128, INC, tid, kraw); vt64_load(P + tile_row0(tn) * INC + C_AV + kvh * 128, INC, tid, vraw); }
        ti = tn;
        f32x4 sacc[2][4];
#pragma unroll
        for (int kt = 0; kt < 4; ++kt) { sacc[0][kt] = (f32x4){0.f, 0.f, 0.f, 0.f}; sacc[1][kt] = (f32x4){0.f, 0.f, 0.f, 0.f}; }
#pragma unroll
        for (int ks = 0; ks < 4; ++ks) {
            const bf16x8 q0f = *(const LAS bf16x8*)(QS + (g * 64 + th * 32 + fr) * AQ_STR + 32 * ks + 8 * quad), q1f = *(const LAS bf16x8*)(QS + (g * 64 + th * 32 + 16 + fr) * AQ_STR + 32 * ks + 8 * quad);
#pragma unroll
            for (int kt = 0; kt < 4; ++kt) { const bf16x8 kf = *(const LAS bf16x8*)(KS + (16 * kt + fr) * AQ_STR + 32 * ks + 8 * quad);
                sacc[0][kt] = MFMA16(kf, q0f, sacc[0][kt]); sacc[1][kt] = MFMA16(kf, q1f, sacc[1][kt]); }
        }
        bf16x8 pf[2][2];
        const bool edge = !isctx && (s0 < q0 - 64 || s0 > q0 + 64);
#pragma unroll
        for (int qt = 0; qt < 2; ++qt) {
            const int tq = q0 + th * 32 + qt * 16 + fr;
            if (edge) {
#pragma unroll
                for (int kt = 0; kt < 4; ++kt)
#pragma unroll
                    for (int r = 0; r < 4; ++r) { const int d = tq - (s0 + 16 * kt + 4 * quad + r); if (d > 128 || d < -128) sacc[qt][kt][r] = -1.0e30f; }
            }
            float mx = fmaxf(fmaxf(sacc[qt][0][0], sacc[qt][0][1]), fmaxf(sacc[qt][0][2], sacc[qt][0][3]));
#pragma unroll
            for (int kt = 1; kt < 4; ++kt) mx = fmaxf(mx, fmaxf(fmaxf(sacc[qt][kt][0], sacc[qt][kt][1]), fmaxf(sacc[qt][kt][2], sacc[qt][kt][3])));
            mx = fmaxf(mx, __shfl_xor(mx, 16)); mx = fmaxf(mx, __shfl_xor(mx, 32));
            if (__any(mx > m[qt])) {
                const float mn = fmaxf(m[qt], mx), alpha = __builtin_amdgcn_exp2f(m[qt] - mn);
                l[qt] *= alpha; m[qt] = mn;
#pragma unroll
                for (int dt = 0; dt < 8; ++dt) oacc[dt][qt] *= alpha;
            }
            const float mq = m[qt]; float rs = 0.f;
#pragma unroll
            for (int kt = 0; kt < 4; ++kt)
#pragma unroll
                for (int r = 0; r < 4; ++r) { const float p = __builtin_amdgcn_exp2f(sacc[qt][kt][r] - mq); sacc[qt][kt][r] = p; rs += p; }
            rs += __shfl_xor(rs, 16); rs += __shfl_xor(rs, 32);
            l[qt] += rs;
#pragma unroll
            for (int s = 0; s < 2; ++s) { u32x4 w; w.x = pk2(sacc[qt][2 * s][0], sacc[qt][2 * s][1]); w.y = pk2(sacc[qt][2 * s][2], sacc[qt][2 * s][3]);
                w.z = pk2(sacc[qt][2 * s + 1][0], sacc[qt][2 * s + 1][1]); w.w = pk2(sacc[qt][2 * s + 1][2], sacc[qt][2 * s + 1][3]); pf[qt][s] = __builtin_bit_cast(bf16x8, w); }
        }
#pragma unroll
        for (int dt = 0; dt < 8; ++dt)
#pragma unroll
            for (int s = 0; s < 2; ++s) {
                const u32x2 v0 = *(const LAS u32x2*)(VT + (16 * dt + fr) * AV_STR + 32 * s + 4 * quad), v1 = *(const LAS u32x2*)(VT + (16 * dt + fr) * AV_STR + 32 * s + 16 + 4 * quad);
                const bf16x8 vf = __builtin_bit_cast(bf16x8, (u32x4){v0.x, v0.y, v1.x, v1.y});
                oacc[dt][0] = MFMA16(vf, pf[0][s], oacc[dt][0]); oacc[dt][1] = MFMA16(vf, pf[1][s], oacc[dt][1]);
            }
    }
#pragma unroll
    for (int qt = 0; qt < 2; ++qt) {
        const float inv = 1.f / l[qt]; const int tq = q0 + th * 32 + qt * 16 + fr;
        bf16* orow = MIX + (size_t)(b * TT + tq) * DM + 1024 + (kvh * 4 + g) * 128;
#pragma unroll
        for (int dt = 0; dt < 8; ++dt) { const f32x4 o = oacc[dt][qt] * inv; *(u32x2*)(orow + 16 * dt + 4 * quad) = (u32x2){pk2(o.x, o.y), pk2(o.z, o.w)}; }
    }
}


__device__ __forceinline__ void readout_row(int row, const float* OF, const float* OB, const bf16* P, const float* ng, bf16* MIX, int lane) {
#pragma unroll
    for (int j = 0; j < 4; ++j) {
        const int e = 4 * lane + 256 * j;
        const f32x4 a = *(const f32x4*)(OF + (size_t)row * 1024 + e), c = *(const f32x4*)(OB + (size_t)row * 1024 + e); const f32x4 o = a + c;
        float ss = (o.x * o.x + o.y * o.y) + (o.z * o.z + o.w * o.w);
        ss += __shfl_xor(ss, 1); ss += __shfl_xor(ss, 2); ss += __shfl_xor(ss, 4); ss += __shfl_xor(ss, 8); ss += __shfl_xor(ss, 16);
        const float rstd = rsqrtf(ss * (1.f / 128.f) + RMS_EPS);
        const f32x4 gm = *(const f32x4*)(ng + (e & 127));
        const u32x2 gw = *(const u32x2*)(P + (size_t)row * INC + C_G + e);
        const float g0 = __uint_as_float(gw.x << 16), g1 = __uint_as_float(gw.x & 0xffff0000u), g2 = __uint_as_float(gw.y << 16), g3 = __uint_as_float(gw.y & 0xffff0000u);
        *(u32x2*)(MIX + (size_t)row * DM + e) = (u32x2){pk2(o.x * rstd * gm.x * siluf_(g0), o.y * rstd * gm.y * siluf_(g1)), pk2(o.z * rstd * gm.z * siluf_(g2), o.w * rstd * gm.w * siluf_(g3))};
    }
}

#define XB_TMO      128
#define XB_XCNT(j)  (256  + 64 * (j))
#define XB_XSUB(j)  (1280 + 64 * (j))
#define XB_XGEN(j)  (2304 + 64 * (j))
#define XB_TOP      3328
#define XB_TOPGEN   3392
#define XCD_BAR_WORDS 3456
#define XB_SPIN_CAP (1u << 18)

__device__ __forceinline__ unsigned xb_ld(unsigned* p)              { return __hip_atomic_load(p, __ATOMIC_RELAXED, __HIP_MEMORY_SCOPE_AGENT); }
__device__ __forceinline__ unsigned xb_add(unsigned* p, unsigned v) { return __hip_atomic_fetch_add(p, v, __ATOMIC_RELAXED, __HIP_MEMORY_SCOPE_AGENT); }
__device__ __forceinline__ unsigned xb_xcc_id() { return (unsigned)__builtin_amdgcn_s_getreg((3 << 11) | 20) & 0xFu; }
#define XB_SPIN(cond, bar) do { unsigned _sp = 0; while (cond) { __builtin_amdgcn_s_sleep(1); \
    if ((++_sp & 255u) == 0u) { if (xb_ld(&(bar)[XB_TMO])) break; if (_sp > XB_SPIN_CAP) { atomicAdd(&(bar)[XB_TMO], 1u); break; } } } } while (0)

struct XcdBarrier {
    unsigned* bar; unsigned x;
    volatile LAS unsigned* st;
};

__device__ __forceinline__ XcdBarrier xcd_barrier_post(unsigned* bar, volatile LAS unsigned* st) {
    XcdBarrier b; b.bar = bar; b.x = xb_xcc_id(); b.st = st;
    if (threadIdx.x == 0) (void)xb_add(&bar[XB_XCNT(b.x)], 1u);
    return b;
}
__device__ __forceinline__ void xcd_barrier_complete(unsigned* bar, unsigned x, unsigned& nloc, unsigned& nx) {
    const unsigned G = gridDim.x * gridDim.y * gridDim.z;
    unsigned sum, cnt, mine, sp = 0u;
    for (;;) {
        sum = 0u; cnt = 0u; mine = 0u;
#pragma unroll
        for (unsigned j = 0; j < 16; ++j) { const unsigned c = xb_ld(&bar[XB_XCNT(j)]); sum += c; cnt += (c > 0u) ? 1u : 0u; mine = (j == x) ? c : mine; }
        if (sum == G) break;
        __builtin_amdgcn_s_sleep(1);
        if ((++sp & 255u) == 0u) { if (xb_ld(&bar[XB_TMO])) break; if (sp > XB_SPIN_CAP) { atomicAdd(&bar[XB_TMO], 1u); break; } }
    }
    nloc = mine > 0u ? mine : 1u; nx = cnt > 0u ? cnt : 1u;
}

__device__ __forceinline__ void xcd_barrier(const XcdBarrier& b) {
    asm volatile("s_waitcnt vmcnt(0)" ::: "memory");
    __syncthreads();
    if (threadIdx.x == 0) {
        unsigned* bar = b.bar;
        __builtin_amdgcn_s_waitcnt(0);
        unsigned nloc = b.st[0], nx = b.st[1];
        if (nloc == 0u) { xcd_barrier_complete(bar, b.x, nloc, nx); b.st[0] = nloc; b.st[1] = nx; }
        const unsigned old = xb_add(&bar[XB_XSUB(b.x)], 1u);
        const unsigned gen = old / nloc;
        if (old + 1u == (gen + 1u) * nloc) {
            __builtin_amdgcn_fence(__ATOMIC_RELEASE, "agent");
            asm volatile("s_waitcnt vmcnt(0)" ::: "memory");
            const unsigned og = xb_add(&bar[XB_TOP], 1u);
            const unsigned tg = og / nx;
            if (og + 1u == (tg + 1u) * nx) xb_add(&bar[XB_TOPGEN], 1u);
            else XB_SPIN(xb_ld(&bar[XB_TOPGEN]) == tg, bar);
            __builtin_amdgcn_fence(__ATOMIC_ACQUIRE, "agent");
            xb_add(&bar[XB_XGEN(b.x)], 1u);
            asm volatile("s_waitcnt vmcnt(0)" ::: "memory");
        } else {
            XB_SPIN(xb_ld(&bar[XB_XGEN(b.x)]) == gen, bar);
            __builtin_amdgcn_fence(__ATOMIC_ACQUIRE, "agent");
            asm volatile("s_waitcnt vmcnt(0)" ::: "memory");
        }
    }
    __syncthreads();
}


constexpr size_t WS_BAR = 512 * 1024, BAR_BYTES = 16384;
constexpr int LDS_MISC = 139264;

struct Args { const float* in[17]; float* out; unsigned char* ws; int ph_lo, ph_hi; };
__global__ void __launch_bounds__(NTHR, 2) fwd_megakernel(Args args) {
    extern __shared__ __attribute__((aligned(16))) unsigned char lds_raw[];
    LAS unsigned char* lds = (LAS unsigned char*)lds_raw;
    cg::grid_group grid = cg::this_grid();
    const int tid = threadIdx.x, lane = tid & 63, wave = __builtin_amdgcn_readfirstlane(tid >> 6);
    const int blk = blockIdx.x, G = gridDim.x, gw = blk * NWAVES + wave, NGW = G * NWAVES;
    unsigned char* ws = args.ws;
    const float* x = args.in[0]; const float* ctx = args.in[2];
    float* MOD = (float*)(ws + WS_MOD); const float* RC = (const float*)(ws + WS_ROPE); const float* RS = RC + 2048;
    bf16* H = (bf16*)(ws + WS_H); bf16* P = (bf16*)(ws + WS_P); bf16* ACT = (bf16*)(ws + WS_ACT); bf16* MIX = (bf16*)(ws + WS_MIX);
    float* OF = (float*)(ws + WS_OF); float* OB = (float*)(ws + WS_OB);
    const int lo = args.ph_lo, hi = args.ph_hi;
    volatile LAS unsigned* bst = (volatile LAS unsigned*)(lds + LDS_MISC);
    if (tid < 2) bst[tid] = 0u;
    __syncthreads();
    XcdBarrier xbar; xbar.bar = (unsigned*)(ws + WS_BAR); xbar.x = 0; xbar.st = bst;
#define IN(k) (lo <= (k) && (k) < hi)
#ifdef PROBE_DUP
#define REP(k) for (int rep_ = 0; rep_ < ((PROBE_DUP) == (k) ? 2 : 1); ++rep_)
#else
#define REP(k)
#endif
#define SEAM(k) do { if (IN(k) && IN((k) + 1)) { \
        if ((k) == 0) { \
            asm volatile("s_waitcnt vmcnt(0) lgkmcnt(0)" ::: "memory"); __syncthreads(); \
            if (tid == 0) { __builtin_amdgcn_fence(__ATOMIC_RELEASE, "agent"); asm volatile("s_waitcnt vmcnt(0)" ::: "memory"); } \
            grid.sync(); \
            if (tid == 0) { __builtin_amdgcn_fence(__ATOMIC_ACQUIRE, "agent"); asm volatile("s_waitcnt vmcnt(0)" ::: "memory"); } \
            __syncthreads(); \
        } else { xcd_barrier(xbar); } } } while (0)

    if (IN(0)) REP(0) { if (blk == 0) for (int i = tid; i < (int)(BAR_BYTES / 4); i += NTHR) ((unsigned*)(ws + WS_BAR))[i] = 0u;
        phase0(args.in, ws, lds, tid, lane, wave); }
    SEAM(0);
    if (lo == 0 && hi > 1) xbar = xcd_barrier_post((unsigned*)(ws + WS_BAR), bst);
    if (IN(1)) REP(1) {
        for (int row = gw; row < MROWS; row += NGW) {
            const float* src = row < NLAT ? x + (size_t)row * DM : ctx + (size_t)(row - NLAT) * DM; const int v = row < NLAT ? row / TT : 2;
            norm_mod_row(src, args.in[6], MOD + v * NMODV, MOD + v * NMODV + DM, H + (size_t)row * DM, lane);
        }
    }
    SEAM(1);
    if (IN(2)) REP(2) {
        pg8::Gemm g{H, (const bf16*)(ws + WS_WIN), MROWS, INC, DM}; pg8::StaticOrder S; S.init(MROWS, INC, G, blk);
        pg8::EpiBf16<0> E{P, INC, nullptr, 0, 0, 1.f};
        pg8::gemm_phase<pg8::EpiBf16<0>, pg8::StaticOrder, true, true>(lds, g, S, E);
        { const int nwg = (MROWS / 256) * (INC / 256), nfull = nwg % G;
          const int first = nfull != 0 ? nfull : 0;
          if (blk >= first) convert_weights(6, args.in, ws, lds, (blk - first) * NWAVES + wave, (G - first) * NWAVES, lane, wave); }
    }
    SEAM(2);
    if (IN(3)) REP(3) { scan_prep(P, args.in[9], ws, args.out, lds, tid, lane, wave); }
    SEAM(3);
    if (IN(4)) REP(4) {
        if (G > NSCAN) { if (blk < NSCAN) {
                             REP(40) scan_apply(blk, ws, args.out, OF, OB, lds, tid, lane, wave); }
                         else {
                             REP(41) for (int u = blk - NSCAN; u < 256; u += G - NSCAN) attn_unit(u, P, args.in[11], args.in[12], args.in[13], RC, RS, MIX, lds, tid, lane, wave); }
                         { const int na = G - NSCAN, first1 = 256 - na > 0 ? 256 - na : 0;
                           if (blk >= NSCAN + first1) { __syncthreads(); convert_weights(8, args.in, ws, lds, (blk - NSCAN - first1) * NWAVES + wave, (na - first1) * NWAVES, lane, wave); } } }
        else { for (int it = blk; it < NSCAN; it += G) scan_apply(it, ws, args.out, OF, OB, lds, tid, lane, wave);
               for (int u = blk; u < 256; u += G) attn_unit(u, P, args.in[11], args.in[12], args.in[13], RC, RS, MIX, lds, tid, lane, wave); }
    }
    SEAM(4);
    if (IN(5)) REP(5) { for (int row = gw; row < NLAT; row += NGW) readout_row(row, OF, OB, P, args.in[10], MIX, lane); }
    SEAM(5);
    if (IN(6)) REP(6) {
        pg8::Gemm g{MIX, (const bf16*)(ws + WS_WOUT), NLAT, DM, DM}; pg8::StaticOrder S; S.init(NLAT, DM, G, blk);
        EpiResGate E{x, args.out, MOD + 2 * DM};
        pg8::gemm_phase<EpiResGate, pg8::StaticOrder, true, true>(lds, g, S, E);
    }
    SEAM(6);
    if (IN(7)) REP(7) {
        for (int row = gw; row < NLAT; row += NGW) { const int v = row / TT;
            norm_mod_row(args.out + (size_t)row * DM, args.in[7], MOD + v * NMODV + 3 * DM, MOD + v * NMODV + 4 * DM, H + (size_t)row * DM, lane); }
    }
    SEAM(7);
    if (IN(8)) REP(8) {
        pg8::Gemm g{H, (const bf16*)(ws + WS_WGU), NLAT, 2 * DFF, DM}; pg8::StaticOrder S; S.init(NLAT, 2 * DFF, G, blk);
        EpiSwiGLU E{ACT};
        pg8::gemm_phase<EpiSwiGLU, pg8::StaticOrder, true, true>(lds, g, S, E);
    }
    SEAM(8);
    if (IN(9)) REP(9) {
        pg8::Gemm g{ACT, (const bf16*)(ws + WS_WDN), NLAT, DM, DFF}; pg8::StaticOrder S; S.init(NLAT, DM, G, blk);
        EpiResGate E{args.out, args.out, MOD + 5 * DM};
        pg8::gemm_phase<EpiResGate, pg8::StaticOrder, true, true>(lds, g, S, E);
    }
#undef IN
#undef SEAM
}

extern "C" void kernel_launch(void* const* d_in, const int* in_sizes, int n_in, void* d_out, int out_size, void* d_ws, size_t ws_size, hipStream_t stream) {
    static int grid = 0;
    if (grid == 0) {
        if (n_in != 17 || ws_size < WS_END) { fprintf(stderr, "kernel_launch: unexpected n_in %d or ws_size %zu\n", n_in, ws_size); grid = -1; return; }
        int dev = 0, cus = 0, per_cu = 0;
        hipGetDevice(&dev); hipDeviceGetAttribute(&cus, hipDeviceAttributeMultiprocessorCount, dev);
        if (hipFuncSetAttribute((const void*)fwd_megakernel, hipFuncAttributeMaxDynamicSharedMemorySize, LDS_BYTES) != hipSuccess) { fprintf(stderr, "hipFuncSetAttribute failed\n"); grid = -1; return; }
        if (hipOccupancyMaxActiveBlocksPerMultiprocessor(&per_cu, (const void*)fwd_megakernel, NTHR, LDS_BYTES) != hipSuccess || per_cu < 1) { fprintf(stderr, "occupancy query failed (%d)\n", per_cu); (void)hipGetLastError(); per_cu = 1; }
        grid = cus * per_cu;
    }
    if (grid < 0) return;
    Args a{};
    for (int i = 0; i < 17; ++i) a.in[i] = (const float*)d_in[i];
    a.out = (float*)d_out; a.ws = (unsigned char*)d_ws; a.ph_lo = 0; a.ph_hi = 10;
#ifndef N_LAUNCH
#define N_LAUNCH 9
#endif
#if N_LAUNCH == 1
    void* kargs[] = {&a};
    hipError_t e = hipLaunchCooperativeKernel((const void*)fwd_megakernel, dim3(grid), dim3(NTHR), kargs, LDS_BYTES, stream);
    if (e != hipSuccess) fprintf(stderr, "cooperative launch failed: %s (grid %d)\n", hipGetErrorString(e), grid);
#else
    for (int p = 0; p < 10; ++p) { a.ph_lo = p; a.ph_hi = p + 1; hipLaunchKernelGGL(fwd_megakernel, dim3(grid), dim3(NTHR), LDS_BYTES, stream, a); }
#endif
}
```

```cpp
#define N_LAUNCH 1
#include <hip/hip_runtime.h>
#include <hip/hip_cooperative_groups.h>
#include <cstdio>
#include <cstdint>
namespace cg = cooperative_groups;
namespace pg8 {
#define PG8_LAS __attribute__((address_space(3)))
typedef unsigned short bf16_t;
typedef short bf16x8 __attribute__((ext_vector_type(8)));
typedef float f32x4 __attribute__((ext_vector_type(4)));
typedef unsigned u32x4 __attribute__((ext_vector_type(4)));
constexpr int BM = 256, BK = 64, HALF = 128, HTB = HALF * BK * 2  , STAGE_BYTES = 8 * HTB, NXCD = 8, WGM = 8;

__host__ __device__ __forceinline__ int lds_byte(int r, int c) { const int st = (r >> 4) * 2 + (c >> 5), rr = r & 15, cc = c & 31, ob = rr * 64 + cc * 2; return st * 1024 + (ob ^ (((ob >> 9) & 1) << 5)); }
__host__ __device__ __forceinline__ void stage_rc(int b, int& R, int& C) { const int st = b / 1024, sb = b % 1024, swz = sb ^ (((sb >> 9) & 1) << 5); R = (st >> 1) * 16 + swz / 64; C = (st & 1) * 32 + (swz % 64) / 2; }
__host__ __device__ __forceinline__ int perm32(int rho) { const int n = rho >> 4, i = rho & 15; return 8 * (i >> 2) + 4 * n + (i & 3); }

struct Unit { int pm, pn; };
struct Gemm { const bf16_t* A; const bf16_t* Bt; int M, N, K; };

struct StaticOrder {
    int nM, nN, nwg, G, c;
    __host__ __device__ void init(int M, int N, int G_, int c_) { nM = M / BM; nN = N / BM; nwg = nM * nN; G = G_; c = c_; }
    __host__ __device__ bool next(int i, Unit& u) const {
        const long L = (long)i * G + c; if (L >= nwg) return false;
        int wgid = (int)L; { const int q = nwg / NXCD, r = nwg % NXCD, xcd = wgid % NXCD, off = wgid / NXCD; wgid = (xcd < r ? xcd * (q + 1) : r * (q + 1) + (xcd - r) * q) + off; }
        const int nig = WGM * nN, gid = wgid / nig, fm = gid * WGM, gsz = (nM - fm) < WGM ? (nM - fm) : WGM;
        u.pm = fm + ((wgid % nig) % gsz); u.pn = (wgid % nig) / gsz; return true;
    }
    __device__ __forceinline__ void a_ready(const Unit&) const {}
    __device__ __forceinline__ void done(const Unit&) const {}
};

__device__ __forceinline__ unsigned cvt_pk_bf16(float lo, float hi) { unsigned r; asm volatile("v_cvt_pk_bf16_f32 %0, %1, %2" : "=v"(r) : "v"(lo), "v"(hi)); return r; }
typedef float f32x2 __attribute__((ext_vector_type(2)));
__device__ __forceinline__ f32x2 gelu_pk(f32x2 v) {
    const f32x2 av = __builtin_elementwise_abs(v), d = av * 0.2316418882f + 1.0f;
    f32x2 t; t.x = __builtin_amdgcn_rcpf(d.x); t.y = __builtin_amdgcn_rcpf(d.y);
    f32x2 q = t * 0.5307027145f + (-0.7265760135f); q = q * t + 0.7107068705f; q = q * t + (-0.142248368f); q = q * t + 0.127414796f; q = q * t;
    const f32x2 s = (v * v) * (-0.72134752044f);
    f32x2 e; e.x = __builtin_amdgcn_exp2f(s.x); e.y = __builtin_amdgcn_exp2f(s.y);
    const f32x2 m = v * (q * e), r = v - m;
    f32x2 o; o.x = v.x < 0.f ? m.x : r.x; o.y = v.y < 0.f ? m.y : r.y; return o;
}

template <int ACT  > struct EpiBf16 {
    static constexpr bool PERM = true, AFTER_DRAIN = false; static_assert(ACT == 0 || ACT == 1, "EpiBf16: ACT is 0 (none) or 1 (gelu_pk)");
    bf16_t* O; int ldc; const float* bias; int split_cols; size_t split_stride; float scale0;
    __device__ __forceinline__ void operator()(const f32x4 (&acc)[2][2][4][2], const Unit& u, int wr, int wc, int fr, int fq) const {
        const int row0 = u.pm * BM + wr * 64 + fr; int colt = u.pn * BM; bf16_t* base = O;
        float sc = 1.f; if (split_cols) { const int t = colt / split_cols; base += (size_t)t * split_stride; colt -= t * split_cols; if (t == 0) sc = scale0; }
        const int col0 = colt + wc * 32 + 8 * fq, bcol0 = u.pn * BM + wc * 32 + 8 * fq;
        f32x4 bv[2][2];
#pragma unroll
        for (int bj = 0; bj < 2; ++bj)
#pragma unroll
            for (int n = 0; n < 2; ++n) bv[bj][n] = bias ? *(const f32x4*)(bias + bcol0 + bj * HALF + 4 * n) : (f32x4){0.f, 0.f, 0.f, 0.f};
#pragma unroll
        for (int ai = 0; ai < 2; ++ai)
#pragma unroll
            for (int m = 0; m < 4; ++m) { bf16_t* rowp = base + (size_t)(row0 + ai * HALF + m * 16) * ldc + col0;
#pragma unroll
                for (int bj = 0; bj < 2; ++bj) { f32x4 v0 = acc[ai][bj][m][0] + bv[bj][0], v1 = acc[ai][bj][m][1] + bv[bj][1];
                    if (ACT == 1) { f32x2 a = gelu_pk((f32x2){v0[0], v0[1]}), b = gelu_pk((f32x2){v0[2], v0[3]}), c = gelu_pk((f32x2){v1[0], v1[1]}), d = gelu_pk((f32x2){v1[2], v1[3]});
                        v0 = (f32x4){a.x, a.y, b.x, b.y}; v1 = (f32x4){c.x, c.y, d.x, d.y}; }
                    v0 = v0 * sc; v1 = v1 * sc; u32x4 w; w.x = cvt_pk_bf16(v0[0], v0[1]); w.y = cvt_pk_bf16(v0[2], v0[3]); w.z = cvt_pk_bf16(v1[0], v1[1]); w.w = cvt_pk_bf16(v1[2], v1[3]);
                    *(u32x4*)(rowp + bj * HALF) = w; } }
    }
};

template <class Epi, class Sched, bool ALIGN_EPI = false, bool SP2 = false>
__device__ __forceinline__ void gemm_phase(PG8_LAS unsigned char* lds, const Gemm g, const Sched& S, const Epi& E) {
    const int tid = threadIdx.x, wid = __builtin_amdgcn_readfirstlane(tid >> 6), lane = tid & 63, wr = wid >> 2, wc = wid & 3, fr = lane & 15, fq = lane >> 4;
    const int K = g.K, nt = K / BK;
    unsigned voffA[2], voffB[2];
#pragma unroll
    for (int i = 0; i < 2; ++i) { int R, C; stage_rc(tid * 16 + i * 8192, R, C); const int Rb = Epi::PERM ? ((R & ~31) + perm32(R & 31)) : R;
        voffA[i] = (unsigned)(R * K + C) * 2u; voffB[i] = (unsigned)(Rb * K + C) * 2u; }
    const size_t kstep = (size_t)(BK * 2);
    const size_t hstep = (size_t)HALF * K * 2;
    const size_t tstep = 2 * hstep;
    const unsigned ldsw = (unsigned)wid * 1024u;
    const int aoff = lds_byte(wr * 64 + fr, fq * 8), boff = lds_byte(wc * 32 + fr, fq * 8);
#define PG8_SA(b, h) (((b) * 2 + (h)) * HTB)
#define PG8_SB(b, h) ((4 + (b) * 2 + (h)) * HTB)
#define PG8_STAGE(bufoff, gbase, voff) do { _Pragma("unroll") for (int _i = 0; _i < 2; ++_i) \
        __builtin_amdgcn_global_load_lds((const unsigned*)((const char*)(gbase) + (voff)[_i]), (PG8_LAS unsigned*)(lds + (bufoff) + ldsw + _i * 8192), 16, 0, 0); } while (0)
#define PG8_LDA(dst, b, h) do { _Pragma("unroll") for (int m = 0; m < 4; ++m) _Pragma("unroll") for (int k = 0; k < 2; ++k) dst[m][k] = *(const PG8_LAS bf16x8*)(lds + PG8_SA(b, h) + aoff + m * 2048 + k * 1024); } while (0)
#define PG8_LDB(dst, b, h) do { _Pragma("unroll") for (int n = 0; n < 2; ++n) _Pragma("unroll") for (int k = 0; k < 2; ++k) dst[n][k] = *(const PG8_LAS bf16x8*)(lds + PG8_SB(b, h) + boff + n * 2048 + k * 1024); } while (0)
#define PG8_MMA(ai, bj, At, Bt) do { __builtin_amdgcn_s_setprio(1); _Pragma("unroll") for (int m = 0; m < 4; ++m) _Pragma("unroll") for (int n = 0; n < 2; ++n) _Pragma("unroll") for (int k = 0; k < 2; ++k) \
        acc[ai][bj][m][n] = __builtin_amdgcn_mfma_f32_16x16x32_bf16(Bt[n][k], At[m][k], acc[ai][bj][m][n], 0, 0, 0); __builtin_amdgcn_s_setprio(0); } while (0)
#define PG8_WAIT_V(n) asm volatile("s_waitcnt vmcnt(" #n ")" ::: "memory")
#define PG8_WAIT_L(n) asm volatile("s_waitcnt lgkmcnt(" #n ")" ::: "memory")
#define PG8_BAR __builtin_amdgcn_s_barrier()
#define PG8_SCHED __builtin_amdgcn_sched_barrier(0)
    Unit cur, nxt; int ui = 0;
    if (!S.next(0, cur)) return;
    f32x4 acc[2][2][4][2];
#pragma unroll
    for (int a = 0; a < 2; ++a)
#pragma unroll
        for (int b = 0; b < 2; ++b)
#pragma unroll
            for (int m = 0; m < 4; ++m)
#pragma unroll
                for (int n = 0; n < 2; ++n) acc[a][b][m][n] = (f32x4){0.f, 0.f, 0.f, 0.f};
    bf16x8 At[4][2], B0[2][2], B1[2][2];
    const char* cA = (const char*)g.A + (size_t)cur.pm * tstep; const char* cB = (const char*)g.Bt + (size_t)cur.pn * tstep;
    S.a_ready(cur);
    if constexpr (SP2) {
        PG8_STAGE(PG8_SB(0, 0), cB, voffB); PG8_STAGE(PG8_SB(0, 1), cB + hstep, voffB); PG8_STAGE(PG8_SA(0, 0), cA, voffA); PG8_STAGE(PG8_SA(0, 1), cA + hstep, voffA);
        if (wr == 1) PG8_BAR;
        PG8_WAIT_V(2); PG8_BAR;
        PG8_STAGE(PG8_SB(1, 0), cB + kstep, voffB); PG8_STAGE(PG8_SA(1, 0), cA + kstep, voffA); PG8_STAGE(PG8_SB(1, 1), cB + hstep + kstep, voffB);
        PG8_WAIT_V(6); PG8_BAR;
    } else {
        PG8_STAGE(PG8_SB(0, 0), cB, voffB); PG8_STAGE(PG8_SA(0, 0), cA, voffA); PG8_STAGE(PG8_SB(0, 1), cB + hstep, voffB); PG8_STAGE(PG8_SA(0, 1), cA + hstep, voffA);
        if (wr == 1) PG8_BAR;
        PG8_WAIT_V(4); PG8_BAR;
        PG8_STAGE(PG8_SB(1, 0), cB + kstep, voffB); PG8_STAGE(PG8_SA(1, 0), cA + kstep, voffA); PG8_STAGE(PG8_SB(1, 1), cB + hstep + kstep, voffB);
        PG8_WAIT_V(6); PG8_BAR;
    }
    for (;;) {
        const bool has_next = S.next(ui + 1, nxt);
        const char* nA = has_next ? (const char*)g.A + (size_t)nxt.pm * tstep : cA; const char* nB = has_next ? (const char*)g.Bt + (size_t)nxt.pn * tstep : cB;
        for (int t = 0; t < nt; t += 2) {
            const bool last = (t == nt - 2);
            const char* a1 = cA + (size_t)(t + 1) * kstep;
            const char* a2 = last ? nA : cA + (size_t)(t + 2) * kstep; const char* b2 = last ? nB : cB + (size_t)(t + 2) * kstep;
            const char* a3 = a2 + kstep; const char* b3 = b2 + kstep;
            if (last && has_next) S.a_ready(nxt);
            if constexpr (SP2) {
            PG8_LDB(B0, 0, 0); PG8_LDB(B1, 0, 1); PG8_SCHED; PG8_LDA(At, 0, 0); PG8_STAGE(PG8_SA(1, 1), a1 + hstep, voffA);
            PG8_WAIT_V(8); PG8_WAIT_L(0); PG8_BAR; PG8_MMA(0, 0, At, B0); PG8_MMA(0, 1, At, B1); PG8_BAR; PG8_SCHED;
            PG8_LDA(At, 0, 1); PG8_STAGE(PG8_SB(0, 0), b2, voffB); PG8_STAGE(PG8_SB(0, 1), b2 + hstep, voffB); PG8_STAGE(PG8_SA(0, 0), a2, voffA);
            PG8_WAIT_V(8); PG8_WAIT_L(0); PG8_BAR; PG8_MMA(1, 0, At, B0); PG8_MMA(1, 1, At, B1); PG8_BAR; PG8_SCHED;
            PG8_LDB(B0, 1, 0); PG8_LDB(B1, 1, 1); PG8_SCHED; PG8_LDA(At, 1, 0); PG8_STAGE(PG8_SA(0, 1), a2 + hstep, voffA);
            PG8_WAIT_V(8); PG8_WAIT_L(0); PG8_BAR; PG8_MMA(0, 0, At, B0); PG8_MMA(0, 1, At, B1); PG8_BAR; PG8_SCHED;
            PG8_LDA(At, 1, 1); PG8_STAGE(PG8_SB(1, 0), b3, voffB); PG8_STAGE(PG8_SB(1, 1), b3 + hstep, voffB); PG8_STAGE(PG8_SA(1, 0), a3, voffA);
            PG8_WAIT_V(8); PG8_WAIT_L(0); PG8_BAR; PG8_MMA(1, 0, At, B0); PG8_MMA(1, 1, At, B1); PG8_BAR; PG8_SCHED;
            } else {
            PG8_LDB(B0, 0, 0); PG8_SCHED; PG8_LDA(At, 0, 0); PG8_STAGE(PG8_SA(1, 1), a1 + hstep, voffA);
            PG8_WAIT_L(8); PG8_BAR; PG8_WAIT_L(0); PG8_MMA(0, 0, At, B0); PG8_BAR; PG8_SCHED;
            PG8_LDB(B1, 0, 1); PG8_STAGE(PG8_SB(0, 0), b2, voffB);
            PG8_BAR; PG8_WAIT_L(0); PG8_MMA(0, 1, At, B1); PG8_BAR;
            PG8_LDA(At, 0, 1); PG8_STAGE(PG8_SA(0, 0), a2, voffA);
            PG8_BAR; PG8_WAIT_L(0); PG8_MMA(1, 0, At, B0); PG8_BAR; PG8_SCHED;
            PG8_STAGE(PG8_SB(0, 1), b2 + hstep, voffB);
            PG8_WAIT_V(6); PG8_BAR; PG8_MMA(1, 1, At, B1); PG8_BAR;
            PG8_LDB(B0, 1, 0); PG8_SCHED; PG8_LDA(At, 1, 0); PG8_STAGE(PG8_SA(0, 1), a2 + hstep, voffA);
            PG8_WAIT_L(8); PG8_BAR; PG8_WAIT_L(0); PG8_MMA(0, 0, At, B0); PG8_BAR; PG8_SCHED;
            PG8_LDB(B1, 1, 1); PG8_STAGE(PG8_SB(1, 0), b3, voffB);
            PG8_BAR; PG8_WAIT_L(0); PG8_MMA(0, 1, At, B1); PG8_BAR;
            PG8_LDA(At, 1, 1); PG8_STAGE(PG8_SA(1, 0), a3, voffA);
            PG8_BAR; PG8_WAIT_L(0); PG8_MMA(1, 0, At, B0); PG8_BAR; PG8_SCHED;
            PG8_STAGE(PG8_SB(1, 1), b3 + hstep, voffB);
            PG8_WAIT_V(6); PG8_BAR; PG8_MMA(1, 1, At, B1); PG8_BAR;
            }
        }
        if constexpr (ALIGN_EPI) { if (wr == 0) PG8_BAR; }
        if constexpr (!Epi::AFTER_DRAIN) { E(acc, cur, wr, wc, fr, fq); S.done(cur); }
        if (!has_next) break;
#pragma unroll
        for (int a = 0; a < 2; ++a)
#pragma unroll
            for (int b = 0; b < 2; ++b)
#pragma unroll
                for (int m = 0; m < 4; ++m)
#pragma unroll
                    for (int n = 0; n < 2; ++n) acc[a][b][m][n] = (f32x4){0.f, 0.f, 0.f, 0.f};
        cur = nxt; cA = nA; cB = nB; ++ui;
        if constexpr (ALIGN_EPI) { if (wr == 1) PG8_BAR; }
    }
    PG8_WAIT_V(0);
    if constexpr (!ALIGN_EPI) { if (wr == 0) PG8_BAR; }
    PG8_BAR;
    if constexpr (Epi::AFTER_DRAIN) { E.fused(acc, cur, wr, wc, fr, fq, lds, wid, lane); S.done(cur); }
#undef PG8_SA
#undef PG8_SB
#undef PG8_STAGE
#undef PG8_LDA
#undef PG8_LDB
#undef PG8_MMA
#undef PG8_WAIT_V
#undef PG8_WAIT_L
#undef PG8_BAR
#undef PG8_SCHED
}
}

#define LAS __attribute__((address_space(3)))
typedef unsigned short bf16;
typedef pg8::f32x4 f32x4;
typedef pg8::bf16x8 bf16x8;
typedef pg8::u32x4 u32x4;
typedef unsigned u32x2 __attribute__((ext_vector_type(2)));

constexpr int DM = 2048, TT = 4096, NB = 2, LC = 256;
constexpr int NLAT = NB * TT, NCTX = NB * LC, MROWS = NLAT + NCTX;
constexpr int INC = 6656, DFF = 5632, NMODV = 12288;
constexpr int C_Q = 0, C_FF = 1024, C_FB = 2048, C_I = 3072, C_G = 4096, C_AQ = 5120, C_AK = 6144, C_AV = 6400;
constexpr float RMS_EPS = 1e-6f;
constexpr int NTHR = 512, NWAVES = 8;
constexpr int NSCAN = 64;

constexpr size_t MiB = 1u << 20;
constexpr size_t WS_MOD = 0, WS_ROPE = 256 * 1024;
constexpr size_t WS_WOUT = 1 * MiB, WS_WGU = 9 * MiB, WS_WDN = 53 * MiB, WS_WIN = 75 * MiB;
constexpr size_t WS_REC0 = 75 * MiB;
constexpr size_t WS_H = 101 * MiB, WS_P = 135 * MiB, WS_ACT = WS_P, WS_OF = 246 * MiB, WS_OB = 278 * MiB, WS_MIX = 310 * MiB, WS_END = 352 * MiB;
constexpr int LDS_BYTES = 143360;

__device__ __forceinline__ float bf2f(unsigned short u) { return __uint_as_float(((unsigned)u) << 16); }
typedef float f32x2_t __attribute__((ext_vector_type(2)));
typedef __bf16 bf16x2_t __attribute__((ext_vector_type(2)));
__device__ __forceinline__ unsigned pk2(float lo, float hi) { const f32x2_t v = {lo, hi}; const bf16x2_t b = __builtin_convertvector(v, bf16x2_t); return __builtin_bit_cast(unsigned, b); }
__device__ __forceinline__ unsigned short f2bf(float x) { const __bf16 b = (__bf16)x; return __builtin_bit_cast(unsigned short, b); }
__device__ __forceinline__ float wave_sum(float v) {
#pragma unroll
    for (int o = 1; o < 64; o <<= 1) v += __shfl_xor(v, o);
    return v;
}
__device__ __forceinline__ float sigmoidf_(float x) { return 1.f / (1.f + __expf(-x)); }
__device__ __forceinline__ float siluf_(float x) { return x / (1.f + __expf(-x)); }

__device__ __forceinline__ void transpose_item(const float* W, int K, int N, bf16* WT, int k0, int n0, int drow, LAS float* scr, int lane) {
    const int kq = lane >> 4, nx = lane & 15;
#pragma unroll 1
    for (int hb = 0; hb < 2; ++hb) {
        f32x4 v[8];
#pragma unroll
        for (int i = 0; i < 8; ++i) v[i] = *(const f32x4*)(W + (size_t)(k0 + 32 * hb + 4 * i + kq) * N + n0 + 4 * nx);
#pragma unroll
        for (int i = 0; i < 8; ++i) { LAS float* d = scr + (4 * nx) * 65 + 32 * hb + 4 * i + kq; d[0] = v[i].x; d[65] = v[i].y; d[130] = v[i].z; d[195] = v[i].w; }
    }
    asm volatile("s_waitcnt lgkmcnt(0)" ::: "memory");
    const int c = lane & 7;
#pragma unroll
    for (int j = 0; j < 8; ++j) { const int n = (lane >> 3) + 8 * j; const LAS float* s = scr + n * 65 + 8 * c;
        u32x4 o; o.x = pk2(s[0], s[1]); o.y = pk2(s[2], s[3]); o.z = pk2(s[4], s[5]); o.w = pk2(s[6], s[7]);
        *(u32x4*)(WT + (size_t)(drow + n) * K + k0 + 8 * c) = o; }
    asm volatile("s_waitcnt lgkmcnt(0)" ::: "memory");
}

__device__ __forceinline__ void convert_weights(int mask, const float* const* in, unsigned char* ws, LAS unsigned char* lds, int w, int nw, int lane, int wave) {
    LAS float* scr = (LAS float*)(lds + wave * 16640);
    const int cnt0 = (mask & 1) ? (DM / 64) * (INC / 64) : 0, cnt1 = (mask & 2) ? (DM / 64) * (DM / 64) : 0, cnt2 = (mask & 4) ? (DFF / 64) * (DM / 64) : 0, cnt3 = (mask & 8) ? (DM / 64) * (2 * DFF / 64) : 0;
#pragma unroll 1
    for (int it = w; it < cnt0 + cnt1 + cnt2 + cnt3; it += nw) {
        int r = it, m = 0;
        if (r >= cnt0) { r -= cnt0; m = 1; if (r >= cnt1) { r -= cnt1; m = 2; if (r >= cnt2) { r -= cnt2; m = 3; } } }
        const float* W = m == 0 ? in[8] : (m == 1 ? in[14] : (m == 2 ? in[16] : in[15]));
        const int K = m == 2 ? DFF : DM, N = m == 0 ? INC : (m == 3 ? 2 * DFF : DM);
        bf16* WT = (bf16*)(ws + (m == 0 ? WS_WIN : (m == 1 ? WS_WOUT : (m == 2 ? WS_WDN : WS_WGU))));
        const int nblk = N / 64, kb = r / nblk, nb = r % nblk, n0 = 64 * nb;
        int drow = n0;
        if (m == 3) { const int half = n0 / DFF, j = n0 % DFF; drow = 256 * (j / 128) + 128 * half + (j % 128); }
        transpose_item(W, K, N, WT, 64 * kb, n0, drow, scr, lane);
    }
}

__device__ __forceinline__ void mod_item(int item, const float* c, const float* c_ctx, const float* w_mod, const float* b_mod, float* MOD, LAS float* L, int tid) {
    LAS float* sv = L;
    LAS float* red = L + 6144;
    for (int i = tid; i < 3 * DM; i += NTHR) { const int v = i / DM, k = i % DM; const float x = v < 2 ? c[v * DM + k] : c_ctx[k]; sv[i] = siluf_(x); }
    __syncthreads();
    const int cl = tid & 15, rl = tid >> 4, col = item * 64 + cl * 4;
    f32x4 a0 = {0.f, 0.f, 0.f, 0.f}, a1 = a0, a2 = a0;
#pragma unroll 8
    for (int k = rl; k < DM; k += 32) { const f32x4 w = *(const f32x4*)(w_mod + (size_t)k * NMODV + col); a0 += w * sv[k]; a1 += w * sv[DM + k]; a2 += w * sv[2 * DM + k]; }
    LAS float* r = red + tid * 12;
    r[0] = a0.x; r[1] = a0.y; r[2] = a0.z; r[3] = a0.w; r[4] = a1.x; r[5] = a1.y; r[6] = a1.z; r[7] = a1.w; r[8] = a2.x; r[9] = a2.y; r[10] = a2.z; r[11] = a2.w;
    __syncthreads();
    if (tid < 16 * 12) { const int cl2 = tid / 12, e = tid % 12; float s = 0.f;
        for (int q = 0; q < 32; ++q) s += red[(q * 16 + cl2) * 12 + e];
        const int v = e >> 2, cc = item * 64 + cl2 * 4 + (e & 3); MOD[v * NMODV + cc] = s + b_mod[cc]; }
    __syncthreads();
}

__device__ __forceinline__ void phase0(const float* const* in, unsigned char* ws, LAS unsigned char* lds, int tid, int lane, int wave) {
    const int blk = blockIdx.x, G = gridDim.x;
    float* MOD = (float*)(ws + WS_MOD);
    __syncthreads();
    for (int item = blk; item < NMODV / 64; item += G) mod_item(item, in[1], in[3], in[4], in[5], MOD, (LAS float*)lds, tid);
    if (blk == G - 1) {
        float* RC = (float*)(ws + WS_ROPE); float* RS = RC + 2048;
        for (int i = tid; i < 2048; i += NTHR) { const int pos = i >> 5, f = i & 31; const double inv = pow(10000.0, -(double)f / 32.0); const float ang = (float)pos * (float)inv;
            RC[i] = (float)cos((double)ang); RS[i] = (float)sin((double)ang); }
    }
    convert_weights(G > NSCAN ? 1 : 9, in, ws, lds, blk * NWAVES + wave, G * NWAVES, lane, wave);
}

__device__ __forceinline__ void norm_mod_row(const float* src, const float* gamma, const float* shift, const float* scale, bf16* dst, int lane) {
    const f32x4* xr = (const f32x4*)src + lane;
    f32x4 v[8]; float ss = 0.f;
#pragma unroll
    for (int j = 0; j < 8; ++j) { v[j] = xr[64 * j]; ss += (v[j].x * v[j].x + v[j].y * v[j].y) + (v[j].z * v[j].z + v[j].w * v[j].w); }
    const float rstd = rsqrtf(wave_sum(ss) * (1.f / DM) + RMS_EPS);
    u32x2* o = (u32x2*)dst + lane;
#pragma unroll
    for (int j = 0; j < 8; ++j) {
        const f32x4 g = ((const f32x4*)gamma)[lane + 64 * j], sh = ((const f32x4*)shift)[lane + 64 * j], sc = ((const f32x4*)scale)[lane + 64 * j];
        const f32x4 y = v[j] * rstd * g; const f32x4 h = y * (sc + 1.f) + sh;
        u32x2 w; w.x = pk2(h.x, h.y); w.y = pk2(h.z, h.w); o[64 * j] = w;
    }
}

struct EpiResGate {
    static constexpr bool PERM = false, AFTER_DRAIN = false;
    const float* base; float* out; const float* gate;
    __device__ __forceinline__ void operator()(const f32x4 (&acc)[2][2][4][2], const pg8::Unit& u, int wr, int wc, int fr, int fq) const {
        const int row0 = u.pm * 256 + wr * 64 + fr, col0 = u.pn * 256 + wc * 32 + 4 * fq;
        const float* gv = gate + (size_t)(u.pm / 16) * NMODV;
#pragma unroll
        for (int bj = 0; bj < 2; ++bj)
#pragma unroll
            for (int n = 0; n < 2; ++n) { const int col = col0 + bj * 128 + n * 16; const f32x4 g = *(const f32x4*)(gv + col);
#pragma unroll
                for (int ai = 0; ai < 2; ++ai)
#pragma unroll
                    for (int m = 0; m < 4; ++m) { const size_t off = (size_t)(row0 + ai * 128 + m * 16) * DM + col;
                        const f32x4 b = *(const f32x4*)(base + off); *(f32x4*)(out + off) = b + g * acc[ai][bj][m][n]; } }
    }
};
struct EpiSwiGLU {
    static constexpr bool PERM = true, AFTER_DRAIN = false;
    bf16* O;
    __device__ __forceinline__ void operator()(const f32x4 (&acc)[2][2][4][2], const pg8::Unit& u, int wr, int wc, int fr, int fq) const {
        const int row0 = u.pm * 256 + wr * 64 + fr, col0 = u.pn * 128 + wc * 32 + 8 * fq;
#pragma unroll
        for (int ai = 0; ai < 2; ++ai)
#pragma unroll
            for (int m = 0; m < 4; ++m) {
                const f32x4 g0 = acc[ai][0][m][0], g1 = acc[ai][0][m][1], u0 = acc[ai][1][m][0], u1 = acc[ai][1][m][1];
                u32x4 w; w.x = pk2(siluf_(g0.x) * u0.x, siluf_(g0.y) * u0.y); w.y = pk2(siluf_(g0.z) * u0.z, siluf_(g0.w) * u0.w);
                w.z = pk2(siluf_(g1.x) * u1.x, siluf_(g1.y) * u1.y); w.w = pk2(siluf_(g1.z) * u1.z, siluf_(g1.w) * u1.w);
                *(u32x4*)(O + (size_t)(row0 + ai * 128 + m * 16) * DFF + col0) = w; }
    }
};


#define MFMA16(a, b, c) __builtin_amdgcn_mfma_f32_16x16x32_bf16((a), (b), (c), 0, 0, 0)
constexpr int SQ_STR = 136;

constexpr int REC_BYTES = 27648, R_QD = 0, R_KRT = 8704, R_VT = 16896, R_SC = 25088, R_DK = 27136;
constexpr int NCHUNK = 136, NITEMS_A = 32 * NCHUNK;
__device__ __forceinline__ unsigned char* rec_ptr(unsigned char* ws, float* dout, int b, int h, int dir, int n) {
    unsigned char* base = dir ? (unsigned char*)dout : ws + WS_REC0; return base + (size_t)((b * 8 + h) * NCHUNK + n) * REC_BYTES; }
__device__ __forceinline__ size_t scan_row(int b, int dir, int n, int s) {
    if (n < 8) { const int p = 32 * n + s; return (size_t)(NLAT + b * LC + (dir ? (LC - 1 - p) : p)); }
    const int p = 32 * (n - 8) + s; return (size_t)(b * TT + (dir ? (TT - 1 - p) : p)); }

__device__ __forceinline__ void scan_prep(const bf16* P, const float* hg_lb, unsigned char* ws, float* dout, LAS unsigned char* lds, int tid, int lane, int wave) {
    LAS bf16* QD = (LAS bf16*)(lds); LAS bf16* KI = (LAS bf16*)(lds + 8704); LAS float* TOT = (LAS float*)(lds + 17408);
    const int k = tid & 127, sg = tid >> 7, fr = lane & 15, quad = lane >> 4, G = gridDim.x;
    const int kp = (k & ~31) | (8 * ((k >> 2) & 3) + 4 * ((k >> 4) & 1) + (k & 3));
    unsigned short rq[8], rf[8], rv[8];
    int it = blockIdx.x;
    if (it < NITEMS_A) { const int n = it % NCHUNK, bhd = it / NCHUNK, dir = bhd & 1, h = (bhd >> 1) & 7, b = bhd >> 4;
#pragma unroll
        for (int j = 0; j < 8; ++j) { const bf16* pr = P + scan_row(b, dir, n, 8 * sg + j) * INC + h * 128 + k; rq[j] = pr[C_Q]; rf[j] = pr[dir ? C_FB : C_FF]; rv[j] = pr[C_I]; } }
    __syncthreads();
    for (; it < NITEMS_A; it += G) {
        const int n = it % NCHUNK, bhd = it / NCHUNK, dir = bhd & 1, h = (bhd >> 1) & 7, b = bhd >> 4;
        unsigned char* rec = rec_ptr(ws, dout, b, h, dir, n);
        const float lb = 1.f / (1.f + __expf(hg_lb[2048 + dir * 1024 + h * 128 + k] - hg_lb[dir * 1024 + h * 128 + k]));
        float lf[8], kk[8], qv[8]; unsigned short vv[8]; float cs = 0.f;
#pragma unroll
        for (int j = 0; j < 8; ++j) { const float fp = bf2f(rf[j]); const float ef = __expf(-fp), sgm = __builtin_amdgcn_rcpf(1.f + ef);
            const float f = lb + (1.f - lb) * sgm; kk[j] = (1.f - lb) * ef * sgm;
            cs += __logf(f); lf[j] = cs; const float qp = bf2f(rq[j]); qv[j] = qp * __builtin_amdgcn_rcpf(1.f + __expf(-qp)); vv[j] = rv[j]; }
        { const int it2 = it + G;
          if (it2 < NITEMS_A) { const int n2 = it2 % NCHUNK, bhd2 = it2 / NCHUNK, dir2 = bhd2 & 1, h2 = (bhd2 >> 1) & 7, b2 = bhd2 >> 4;
#pragma unroll
            for (int j = 0; j < 8; ++j) { const bf16* pr = P + scan_row(b2, dir2, n2, 8 * sg + j) * INC + h2 * 128 + k; rq[j] = pr[C_Q]; rf[j] = pr[dir2 ? C_FB : C_FF]; rv[j] = pr[C_I]; } } }
        TOT[sg * 128 + k] = cs;
        __syncthreads();
        const float t0 = TOT[k], t1 = TOT[128 + k], t2 = TOT[256 + k], t3 = TOT[384 + k];
        const float off = sg == 0 ? 0.f : (sg == 1 ? t0 : (sg == 2 ? t0 + t1 : t0 + t1 + t2)), blast = (t0 + t1) + (t2 + t3);
        unsigned krp[4];
        const float eb = __expf(blast);
#pragma unroll
        for (int j = 0; j < 8; j += 2) {
            const float b0 = off + lf[j], b1 = off + lf[j + 1];
            const float e0 = __expf(b0), e1 = __expf(b1), i0 = __builtin_amdgcn_rcpf(e0), i1 = __builtin_amdgcn_rcpf(e1);
            if (n >= 8) {
                const unsigned short q0 = f2bf(qv[j] * e0), q1 = f2bf(qv[j + 1] * e1);
                QD[(8 * sg + j) * SQ_STR + kp] = q0; QD[(8 * sg + j + 1) * SQ_STR + kp] = q1;
                ((bf16*)(rec + R_QD))[(8 * sg + j) * SQ_STR + kp] = q0; ((bf16*)(rec + R_QD))[(8 * sg + j + 1) * SQ_STR + kp] = q1;
                KI[(8 * sg + j) * SQ_STR + kp] = f2bf(kk[j] * i0); KI[(8 * sg + j + 1) * SQ_STR + kp] = f2bf(kk[j + 1] * i1);
            }
            krp[j >> 1] = pk2(kk[j] * (eb * i0), kk[j + 1] * (eb * i1));
        }
        *(u32x4*)(rec + R_KRT + k * 64 + ((sg ^ ((k >> 2) & 3)) * 16)) = (u32x4){krp[0], krp[1], krp[2], krp[3]};
        *(u32x4*)(rec + R_VT + k * 64 + ((sg ^ ((k >> 2) & 3)) * 16)) = (u32x4){(unsigned)vv[0] | ((unsigned)vv[1] << 16), (unsigned)vv[2] | ((unsigned)vv[3] << 16), (unsigned)vv[4] | ((unsigned)vv[5] << 16), (unsigned)vv[6] | ((unsigned)vv[7] << 16)};
        if (sg == 0) ((float*)(rec + R_DK))[k] = eb;
        __syncthreads();
        if (n >= 8 && wave < 4) {
            const int ct = wave >> 1, st = wave & 1; f32x4 a = {0.f, 0.f, 0.f, 0.f};
#pragma unroll
            for (int ks = 0; ks < 4; ++ks) { const bf16x8 af = *(const LAS bf16x8*)(QD + (16 * ct + fr) * SQ_STR + 32 * ks + 8 * quad); const bf16x8 bfr = *(const LAS bf16x8*)(KI + (16 * st + fr) * SQ_STR + 32 * ks + 8 * quad);
                a = MFMA16(af, bfr, a); }
#pragma unroll
            for (int r = 0; r < 4; ++r) { const int c = 16 * ct + 4 * quad + r, s2 = 16 * st + fr; ((bf16*)(rec + R_SC))[c * 32 + ((((s2 >> 3) ^ ((c >> 2) & 3))) << 3) + (s2 & 7)] = f2bf(s2 <= c ? a[r] : 0.f); }
        }
    }
    __syncthreads();
}

__device__ __forceinline__ void scan_apply(int item, unsigned char* ws, float* dout, float* OF, float* OB, LAS unsigned char* lds, int tid, int lane, int wave) {
    const int vh = item & 1, dir = (item >> 1) & 1, h = (item >> 2) & 7, b = item >> 5, fr = lane & 15, quad = lane >> 4;
    float* OUT = dir ? OB : OF;
    const unsigned char* rec0 = rec_ptr(ws, dout, b, h, dir, 0);
    const int swz = quad ^ ((fr >> 2) & 3);
    const bool active = wave < 4;
    const int vtile = 4 * vh + (wave & 3);
    f32x4 Sacc[8];
#pragma unroll
    for (int kt = 0; kt < 8; ++kt) Sacc[kt] = (f32x4){0.f, 0.f, 0.f, 0.f};
    constexpr int NSLOT = 5;
    const int npre = vh ? 17 : 21;
#define SA_STAGE(chunk) do { const int _c = (chunk) < NCHUNK ? (chunk) : NCHUNK - 1; const unsigned char* _g = rec0 + (size_t)_c * REC_BYTES + lane * 16; LAS unsigned char* _l = lds + ((chunk) % NSLOT) * REC_BYTES; \
        _Pragma("unroll") for (int _i = 0; _i < 6; ++_i) { const int _j = (wave - 4) * 6 + _i; const int _p = _j < npre ? _j : _j + 3;     \
            __builtin_amdgcn_global_load_lds((const unsigned*)(_g + _p * 1024), (LAS unsigned*)(_l + _p * 1024), 16, 0, 0); } } while (0)
    __syncthreads();
    if (!active) { SA_STAGE(0); SA_STAGE(1); SA_STAGE(2); SA_STAGE(3); }
    const long rstep = dir ? -1024 : 1024;
#define SA_HEAD(n) do { if (!active) asm volatile("s_waitcnt vmcnt(18)" ::: "memory");     \
        __builtin_amdgcn_s_barrier(); asm volatile("" ::: "memory"); \
        if (!active) SA_STAGE((n) + 4);                                } while (0)
    for (int n = 0; n < 8; ++n) {
        SA_HEAD(n);
        if (active) {
            const LAS unsigned char* slot = lds + (n % NSLOT) * REC_BYTES;
            const bf16x8 vfr = *(const LAS bf16x8*)(slot + R_VT + (16 * vtile + fr) * 64 + swz * 16);
#pragma unroll
            for (int kt = 0; kt < 8; ++kt) {
                const f32x4 d = *(const LAS f32x4*)(slot + R_DK + (16 * kt + 4 * quad) * 4);
                const bf16x8 af = *(const LAS bf16x8*)(slot + R_KRT + (16 * kt + fr) * 64 + swz * 16);
                Sacc[kt] = MFMA16(af, vfr, Sacc[kt] * d);
            }
        }
    }
    for (int n = 8; n < NCHUNK; ++n) {
        SA_HEAD(n);
        if (active) {
            const LAS unsigned char* slot = lds + (n % NSLOT) * REC_BYTES;
            const bf16x8 vfr = *(const LAS bf16x8*)(slot + R_VT + (16 * vtile + fr) * 64 + swz * 16);
            bf16x8 sb[4];
#pragma unroll
            for (int ks = 0; ks < 4; ++ks) sb[ks] = __builtin_bit_cast(bf16x8, (u32x4){pk2(Sacc[2 * ks].x, Sacc[2 * ks].y), pk2(Sacc[2 * ks].z, Sacc[2 * ks].w), pk2(Sacc[2 * ks + 1].x, Sacc[2 * ks + 1].y), pk2(Sacc[2 * ks + 1].z, Sacc[2 * ks + 1].w)});
            float* op = OUT + scan_row(b, dir, n, 4 * quad) * 1024 + h * 128 + 16 * vtile + fr;
            f32x4 o0 = {0.f, 0.f, 0.f, 0.f}, o1 = o0;
            { const bf16x8 a0 = *(const LAS bf16x8*)(slot + R_SC + (fr) * 64 + swz * 16), a1 = *(const LAS bf16x8*)(slot + R_SC + (16 + fr) * 64 + swz * 16); o0 = MFMA16(a0, vfr, o0); o1 = MFMA16(a1, vfr, o1); }
#pragma unroll
            for (int ks = 0; ks < 4; ++ks) {
                const bf16x8 a0 = *(const LAS bf16x8*)(slot + R_QD + (fr) * (SQ_STR * 2) + (32 * ks + 8 * quad) * 2), a1 = *(const LAS bf16x8*)(slot + R_QD + (16 + fr) * (SQ_STR * 2) + (32 * ks + 8 * quad) * 2);
                o0 = MFMA16(a0, sb[ks], o0); o1 = MFMA16(a1, sb[ks], o1);
#pragma unroll
                for (int kk2 = 0; kk2 < 2; ++kk2) { const int kt = 2 * ks + kk2;
                    const f32x4 d = *(const LAS f32x4*)(slot + R_DK + (16 * kt + 4 * quad) * 4);
                    const bf16x8 af = *(const LAS bf16x8*)(slot + R_KRT + (16 * kt + fr) * 64 + swz * 16);
                    Sacc[kt] = MFMA16(af, vfr, Sacc[kt] * d); }
            }
#pragma unroll
            for (int r = 0; r < 4; ++r) { op[r * rstep] = o0[r]; op[(16 + r) * rstep] = o1[r]; }
        }
    }
#undef SA_HEAD
    asm volatile("s_waitcnt vmcnt(0)" ::: "memory");
    __syncthreads();
#undef SA_STAGE
}

constexpr int AQ_STR = 136, AV_STR = 72;
constexpr int AT_OFF_Q = 0, AT_OFF_K = 256 * AQ_STR * 2, AT_OFF_VT = AT_OFF_K + 64 * AQ_STR * 2;
__device__ __forceinline__ void rows64_load(const bf16* src0, size_t row_stride, int tid, u32x2 (&raw)[4]) {
    const bf16* src = src0 + (size_t)(tid >> 3) * row_stride + (tid & 7) * 4;
#pragma unroll
    for (int g = 0; g < 4; ++g) raw[g] = *(const u32x2*)(src + 32 * g);
}
__device__ __forceinline__ void rows64_proc(const u32x2 (&raw)[4], int pos0, bool rope, const float* gamma, const float* RC, const float* RS, LAS bf16* dst, int tid, float mul) {
    const int rr = tid >> 3, sub = tid & 7;
    float y[4][4]; float ss = 0.f;
#pragma unroll
    for (int g = 0; g < 4; ++g) { const u32x2 w = raw[g];
        y[g][0] = __uint_as_float(w.x << 16); y[g][1] = __uint_as_float(w.x & 0xffff0000u); y[g][2] = __uint_as_float(w.y << 16); y[g][3] = __uint_as_float(w.y & 0xffff0000u);
        ss += (y[g][0] * y[g][0] + y[g][1] * y[g][1]) + (y[g][2] * y[g][2] + y[g][3] * y[g][3]); }
    ss += __shfl_xor(ss, 1); ss += __shfl_xor(ss, 2); ss += __shfl_xor(ss, 4);
    const float rstd = rsqrtf(ss * (1.f / 128.f) + RMS_EPS) * mul;
#pragma unroll
    for (int g = 0; g < 4; ++g) { const f32x4 gm = *(const f32x4*)(gamma + sub * 4 + 32 * g);
        y[g][0] *= rstd * gm.x; y[g][1] *= rstd * gm.y; y[g][2] *= rstd * gm.z; y[g][3] *= rstd * gm.w; }
    if (rope) {
        const int pos = pos0 + rr, prow = pos >> 6, pcol = pos & 63;
        const f32x4 cr = *(const f32x4*)(RC + prow * 32 + sub * 4), sr = *(const f32x4*)(RS + prow * 32 + sub * 4), cc = *(const f32x4*)(RC + pcol * 32 + sub * 4), sc = *(const f32x4*)(RS + pcol * 32 + sub * 4);
#pragma unroll
        for (int e = 0; e < 4; ++e) { const float a = y[0][e], bb = y[1][e]; y[0][e] = a * cr[e] - bb * sr[e]; y[1][e] = a * sr[e] + bb * cr[e];
            const float a2 = y[2][e], b2 = y[3][e]; y[2][e] = a2 * cc[e] - b2 * sc[e]; y[3][e] = a2 * sc[e] + b2 * cc[e]; }
    }
#pragma unroll
    for (int g = 0; g < 4; ++g) *(LAS u32x2*)(dst + rr * AQ_STR + sub * 4 + 32 * g) = (u32x2){pk2(y[g][0], y[g][1]), pk2(y[g][2], y[g][3])};
}
__device__ __forceinline__ void vt64_load(const bf16* src0, size_t row_stride, int tid, u32x2 (&x)[4]) {
    const int kg = tid & 15, dg = tid >> 4;
#pragma unroll
    for (int i = 0; i < 4; ++i) x[i] = *(const u32x2*)(src0 + (size_t)(4 * kg + i) * row_stride + 4 * dg);
}
__device__ __forceinline__ void vt64_store(const u32x2 (&x)[4], LAS bf16* VT, int tid) {
    const int kg = tid & 15, dg = tid >> 4;
    const unsigned e0[4] = {x[0].x & 0xffffu, x[1].x & 0xffffu, x[2].x & 0xffffu, x[3].x & 0xffffu};
    const unsigned e1[4] = {x[0].x >> 16, x[1].x >> 16, x[2].x >> 16, x[3].x >> 16};
    const unsigned e2[4] = {x[0].y & 0xffffu, x[1].y & 0xffffu, x[2].y & 0xffffu, x[3].y & 0xffffu};
    const unsigned e3[4] = {x[0].y >> 16, x[1].y >> 16, x[2].y >> 16, x[3].y >> 16};
    *(LAS u32x2*)(VT + (4 * dg + 0) * AV_STR + 4 * kg) = (u32x2){e0[0] | (e0[1] << 16), e0[2] | (e0[3] << 16)};
    *(LAS u32x2*)(VT + (4 * dg + 1) * AV_STR + 4 * kg) = (u32x2){e1[0] | (e1[1] << 16), e1[2] | (e1[3] << 16)};
    *(LAS u32x2*)(VT + (4 * dg + 2) * AV_STR + 4 * kg) = (u32x2){e2[0] | (e2[1] << 16), e2[2] | (e2[3] << 16)};
    *(LAS u32x2*)(VT + (4 * dg + 3) * AV_STR + 4 * kg) = (u32x2){e3[0] | (e3[1] << 16), e3[2] | (e3[3] << 16)};
}

__device__ __forceinline__ void attn_unit(int unit, const bf16* P, const float* q_g, const float* k_g, const float* sink, const float* RC, const float* RS, bf16* MIX,
                                          LAS unsigned char* lds, int tid, int lane, int wave) {
    const int b = unit >> 7, kvh = (unit >> 6) & 1, qb = unit & 63, q0 = qb * 64;
    LAS bf16* QS = (LAS bf16*)(lds + AT_OFF_Q); LAS bf16* KS = (LAS bf16*)(lds + AT_OFF_K); LAS bf16* VT = (LAS bf16*)(lds + AT_OFF_VT);
    const int fr = lane & 15, quad = lane >> 4, g = wave >> 1, th = wave & 1;
    const float LOG2E = 1.4426950408889634f, cscale = 0.08838834764831845f * LOG2E;
    __syncthreads();
    auto tile_s0 = [&](int ti) -> int { return ti < 4 ? 64 * ti : q0 - 128 + 64 * (ti - 4); };
    auto tile_row0 = [&](int ti) -> size_t { const int s0 = tile_s0(ti); return ti < 4 ? (size_t)(NLAT + b * LC + s0) : (size_t)(b * TT + s0); };
    auto next_tile = [&](int ti) -> int { ++ti; while (ti < 9 && ti >= 4 && (tile_s0(ti) < 0 || tile_s0(ti) >= TT)) ++ti; return ti; };
    u32x2 kraw[4], vraw[4];
#pragma unroll 1
    for (int gp = 0; gp < 2; ++gp) { u32x2 qraw[2][4];
#pragma unroll
      for (int gg = 0; gg < 2; ++gg) rows64_load(P + (size_t)(b * TT + q0) * INC + C_AQ + (kvh * 4 + 2 * gp + gg) * 128, INC, tid, qraw[gg]);
      if (gp == 1) { rows64_load(P + tile_row0(0) * INC + C_AK + kvh * 128, INC, tid, kraw); vt64_load(P + tile_row0(0) * INC + C_AV + kvh * 128, INC, tid, vraw); }
#pragma unroll
      for (int gg = 0; gg < 2; ++gg) rows64_proc(qraw[gg], q0, true, q_g, RC, RS, QS + (2 * gp + gg) * 64 * AQ_STR, tid, cscale); }
    __syncthreads();
    float m[2], l[2];
    m[0] = m[1] = sink[kvh * 4 + g] * LOG2E; l[0] = l[1] = 1.f;
    f32x4 oacc[8][2];
#pragma unroll
    for (int dt = 0; dt < 8; ++dt) { oacc[dt][0] = (f32x4){0.f, 0.f, 0.f, 0.f}; oacc[dt][1] = (f32x4){0.f, 0.f, 0.f, 0.f}; }
#pragma unroll 1
    for (int ti = 0; ti < 9; ) {
        const bool isctx = ti < 4; const int s0 = tile_s0(ti);
        __syncthreads();
        rows64_proc(kraw, s0, !isctx, k_g, RC, RS, KS, tid, 1.f);
        vt64_store(vraw, VT, tid);
        __syncthreads();
        const int tn = next_tile(ti);
        if (tn < 9) { rows64_load(P + tile_row0(tn) * INC + C_AK + kvh * 128, INC, tid, kraw); vt64_load(P + tile_row0(tn) * INC + C_AV + kvh * 128, INC, tid, vraw); }
        ti = tn;
        f32x4 sacc[2][4];
#pragma unroll
        for (int kt = 0; kt < 4; ++kt) { sacc[0][kt] = (f32x4){0.f, 0.f, 0.f, 0.f}; sacc[1][kt] = (f32x4){0.f, 0.f, 0.f, 0.f}; }
#pragma unroll
        for (int ks = 0; ks < 4; ++ks) {
            const bf16x8 q0f = *(const LAS bf16x8*)(QS + (g * 64 + th * 32 + fr) * AQ_STR + 32 * ks + 8 * quad), q1f = *(const LAS bf16x8*)(QS + (g * 64 + th * 32 + 16 + fr) * AQ_STR + 32 * ks + 8 * quad);
#pragma unroll
            for (int kt = 0; kt < 4; ++kt) { const bf16x8 kf = *(const LAS bf16x8*)(KS + (16 * kt + fr) * AQ_STR + 32 * ks + 8 * quad);
                sacc[0][kt] = MFMA16(kf, q0f, sacc[0][kt]); sacc[1][kt] = MFMA16(kf, q1f, sacc[1][kt]); }
        }
        bf16x8 pf[2][2];
        const bool edge = !isctx && (s0 < q0 - 64 || s0 > q0 + 64);
#pragma unroll
        for (int qt = 0; qt < 2; ++qt) {
            const int tq = q0 + th * 32 + qt * 16 + fr;
            if (edge) {
#pragma unroll
                for (int kt = 0; kt < 4; ++kt)
#pragma unroll
                    for (int r = 0; r < 4; ++r) { const int d = tq - (s0 + 16 * kt + 4 * quad + r); if (d > 128 || d < -128) sacc[qt][kt][r] = -1.0e30f; }
            }
            float mx = fmaxf(fmaxf(sacc[qt][0][0], sacc[qt][0][1]), fmaxf(sacc[qt][0][2], sacc[qt][0][3]));
#pragma unroll
            for (int kt = 1; kt < 4; ++kt) mx = fmaxf(mx, fmaxf(fmaxf(sacc[qt][kt][0], sacc[qt][kt][1]), fmaxf(sacc[qt][kt][2], sacc[qt][kt][3])));
            mx = fmaxf(mx, __shfl_xor(mx, 16)); mx = fmaxf(mx, __shfl_xor(mx, 32));
            if (__any(mx > m[qt])) {
                const float mn = fmaxf(m[qt], mx), alpha = __builtin_amdgcn_exp2f(m[qt] - mn);
                l[qt] *= alpha; m[qt] = mn;
#pragma unroll
                for (int dt = 0; dt < 8; ++dt) oacc[dt][qt] *= alpha;
            }
            const float mq = m[qt]; float rs = 0.f;
#pragma unroll
            for (int kt = 0; kt < 4; ++kt)
#pragma unroll
                for (int r = 0; r < 4; ++r) { const float p = __builtin_amdgcn_exp2f(sacc[qt][kt][r] - mq); sacc[qt][kt][r] = p; rs += p; }
            rs += __shfl_xor(rs, 16); rs += __shfl_xor(rs, 32);
            l[qt] += rs;
#pragma unroll
            for (int s = 0; s < 2; ++s) { u32x4 w; w.x = pk2(sacc[qt][2 * s][0], sacc[qt][2 * s][1]); w.y = pk2(sacc[qt][2 * s][2], sacc[qt][2 * s][3]);
                w.z = pk2(sacc[qt][2 * s + 1][0], sacc[qt][2 * s + 1][1]); w.w = pk2(sacc[qt][2 * s + 1][2], sacc[qt][2 * s + 1][3]); pf[qt][s] = __builtin_bit_cast(bf16x8, w); }
        }
#pragma unroll
        for (int dt = 0; dt < 8; ++dt)
#pragma unroll
            for (int s = 0; s < 2; ++s) {
                const u32x2 v0 = *(const LAS u32x2*)(VT + (16 * dt + fr) * AV_STR + 32 * s + 4 * quad), v1 = *(const LAS u32x2*)(VT + (16 * dt + fr) * AV_STR + 32 * s + 16 + 4 * quad);
                const bf16x8 vf = __builtin_bit_cast(bf16x8, (u32x4){v0.x, v0.y, v1.x, v1.y});
                oacc[dt][0] = MFMA16(vf, pf[0][s], oacc[dt][0]); oacc[dt][1] = MFMA16(vf, pf[1][s], oacc[dt][1]);
            }
    }
#pragma unroll
    for (int qt = 0; qt < 2; ++qt) {
        const float inv = 1.f / l[qt]; const int tq = q0 + th * 32 + qt * 16 + fr;
        bf16* orow = MIX + (size_t)(b * TT + tq) * DM + 1024 + (kvh * 4 + g) * 128;
#pragma unroll
        for (int dt = 0; dt < 8; ++dt) { const f32x4 o = oacc[dt][qt] * inv; *(u32x2*)(orow + 16 * dt + 4 * quad) = (u32x2){pk2(o.x, o.y), pk2(o.z, o.w)}; }
    }
}


__device__ __forceinline__ void readout_row(int row, const float* OF, const float* OB, const bf16* P, const float* ng, bf16* MIX, int lane) {
#pragma unroll
    for (int j = 0; j < 4; ++j) {
        const int e = 4 * lane + 256 * j;
        const f32x4 a = *(const f32x4*)(OF + (size_t)row * 1024 + e), c = *(const f32x4*)(OB + (size_t)row * 1024 + e); const f32x4 o = a + c;
        float ss = (o.x * o.x + o.y * o.y) + (o.z * o.z + o.w * o.w);
        ss += __shfl_xor(ss, 1); ss += __shfl_xor(ss, 2); ss += __shfl_xor(ss, 4); ss += __shfl_xor(ss, 8); ss += __shfl_xor(ss, 16);
        const float rstd = rsqrtf(ss * (1.f / 128.f) + RMS_EPS);
        const f32x4 gm = *(const f32x4*)(ng + (e & 127));
        const u32x2 gw = *(const u32x2*)(P + (size_t)row * INC + C_G + e);
        const float g0 = __uint_as_float(gw.x << 16), g1 = __uint_as_float(gw.x & 0xffff0000u), g2 = __uint_as_float(gw.y << 16), g3 = __uint_as_float(gw.y & 0xffff0000u);
        *(u32x2*)(MIX + (size_t)row * DM + e) = (u32x2){pk2(o.x * rstd * gm.x * siluf_(g0), o.y * rstd * gm.y * siluf_(g1)), pk2(o.z * rstd * gm.z * siluf_(g2), o.w * rstd * gm.w * siluf_(g3))};
    }
}

#define XB_TMO      128
#define XB_XCNT(j)  (256  + 64 * (j))
#define XB_XSUB(j)  (1280 + 64 * (j))
#define XB_XGEN(j)  (2304 + 64 * (j))
#define XB_TOP      3328
#define XB_TOPGEN   3392
#define XCD_BAR_WORDS 3456
#define XB_SPIN_CAP (1u << 18)

__device__ __forceinline__ unsigned xb_ld(unsigned* p)              { return __hip_atomic_load(p, __ATOMIC_RELAXED, __HIP_MEMORY_SCOPE_AGENT); }
__device__ __forceinline__ unsigned xb_add(unsigned* p, unsigned v) { return __hip_atomic_fetch_add(p, v, __ATOMIC_RELAXED, __HIP_MEMORY_SCOPE_AGENT); }
__device__ __forceinline__ unsigned xb_xcc_id() { return (unsigned)__builtin_amdgcn_s_getreg((3 << 11) | 20) & 0xFu; }
#define XB_SPIN(cond, bar) do { unsigned _sp = 0; while (cond) { __builtin_amdgcn_s_sleep(1); \
    if ((++_sp & 255u) == 0u) { if (xb_ld(&(bar)[XB_TMO])) break; if (_sp > XB_SPIN_CAP) { atomicAdd(&(bar)[XB_TMO], 1u); break; } } } } while (0)

struct XcdBarrier {
    unsigned* bar; unsigned x;
    volatile LAS unsigned* st;
};

__device__ __forceinline__ XcdBarrier xcd_barrier_post(unsigned* bar, volatile LAS unsigned* st) {
    XcdBarrier b; b.bar = bar; b.x = xb_xcc_id(); b.st = st;
    if (threadIdx.x == 0) (void)xb_add(&bar[XB_XCNT(b.x)], 1u);
    return b;
}
__device__ __forceinline__ void xcd_barrier_complete(unsigned* bar, unsigned x, unsigned& nloc, unsigned& nx) {
    const unsigned G = gridDim.x * gridDim.y * gridDim.z;
    unsigned sum, cnt, mine, sp = 0u;
    for (;;) {
        sum = 0u; cnt = 0u; mine = 0u;
#pragma unroll
        for (unsigned j = 0; j < 16; ++j) { const unsigned c = xb_ld(&bar[XB_XCNT(j)]); sum += c; cnt += (c > 0u) ? 1u : 0u; mine = (j == x) ? c : mine; }
        if (sum == G) break;
        __builtin_amdgcn_s_sleep(1);
        if ((++sp & 255u) == 0u) { if (xb_ld(&bar[XB_TMO])) break; if (sp > XB_SPIN_CAP) { atomicAdd(&bar[XB_TMO], 1u); break; } }
    }
    nloc = mine > 0u ? mine : 1u; nx = cnt > 0u ? cnt : 1u;
}

__device__ __forceinline__ void xcd_barrier(const XcdBarrier& b) {
    asm volatile("s_waitcnt vmcnt(0)" ::: "memory");
    __syncthreads();
    if (threadIdx.x == 0) {
        unsigned* bar = b.bar;
        __builtin_amdgcn_s_waitcnt(0);
        unsigned nloc = b.st[0], nx = b.st[1];
        if (nloc == 0u) { xcd_barrier_complete(bar, b.x, nloc, nx); b.st[0] = nloc; b.st[1] = nx; }
        const unsigned old = xb_add(&bar[XB_XSUB(b.x)], 1u);
        const unsigned gen = old / nloc;
        if (old + 1u == (gen + 1u) * nloc) {
            __builtin_amdgcn_fence(__ATOMIC_RELEASE, "agent");
            asm volatile("s_waitcnt vmcnt(0)" ::: "memory");
            const unsigned og = xb_add(&bar[XB_TOP], 1u);
            const unsigned tg = og / nx;
            if (og + 1u == (tg + 1u) * nx) xb_add(&bar[XB_TOPGEN], 1u);
            else XB_SPIN(xb_ld(&bar[XB_TOPGEN]) == tg, bar);
            __builtin_amdgcn_fence(__ATOMIC_ACQUIRE, "agent");
            xb_add(&bar[XB_XGEN(b.x)], 1u);
            asm volatile("s_waitcnt vmcnt(0)" ::: "memory");
        } else {
            XB_SPIN(xb_ld(&bar[XB_XGEN(b.x)]) == gen, bar);
            __builtin_amdgcn_fence(__ATOMIC_ACQUIRE, "agent");
            asm volatile("s_waitcnt vmcnt(0)" ::: "memory");
        }
    }
    __syncthreads();
}


constexpr size_t WS_BAR = 512 * 1024, BAR_BYTES = 16384;
constexpr int LDS_MISC = 139264;

struct Args { const float* in[17]; float* out; unsigned char* ws; int ph_lo, ph_hi; };
__global__ void __launch_bounds__(NTHR, 2) fwd_megakernel(Args args) {
    extern __shared__ __attribute__((aligned(16))) unsigned char lds_raw[];
    LAS unsigned char* lds = (LAS unsigned char*)lds_raw;
    cg::grid_group grid = cg::this_grid();
    const int tid = threadIdx.x, lane = tid & 63, wave = __builtin_amdgcn_readfirstlane(tid >> 6);
    const int blk = blockIdx.x, G = gridDim.x, gw = blk * NWAVES + wave, NGW = G * NWAVES;
    unsigned char* ws = args.ws;
    const float* x = args.in[0]; const float* ctx = args.in[2];
    float* MOD = (float*)(ws + WS_MOD); const float* RC = (const float*)(ws + WS_ROPE); const float* RS = RC + 2048;
    bf16* H = (bf16*)(ws + WS_H); bf16* P = (bf16*)(ws + WS_P); bf16* ACT = (bf16*)(ws + WS_ACT); bf16* MIX = (bf16*)(ws + WS_MIX);
    float* OF = (float*)(ws + WS_OF); float* OB = (float*)(ws + WS_OB);
    const int lo = args.ph_lo, hi = args.ph_hi;
    volatile LAS unsigned* bst = (volatile LAS unsigned*)(lds + LDS_MISC);
    if (tid < 2) bst[tid] = 0u;
    __syncthreads();
    XcdBarrier xbar; xbar.bar = (unsigned*)(ws + WS_BAR); xbar.x = 0; xbar.st = bst;
#define IN(k) (lo <= (k) && (k) < hi)
#ifdef PROBE_DUP
#define REP(k) for (int rep_ = 0; rep_ < ((PROBE_DUP) == (k) ? 2 : 1); ++rep_)
#else
#define REP(k)
#endif
#define SEAM(k) do { if (IN(k) && IN((k) + 1)) { \
        if ((k) == 0) { \
            asm volatile("s_waitcnt vmcnt(0) lgkmcnt(0)" ::: "memory"); __syncthreads(); \
            if (tid == 0) { __builtin_amdgcn_fence(__ATOMIC_RELEASE, "agent"); asm volatile("s_waitcnt vmcnt(0)" ::: "memory"); } \
            grid.sync(); \
            if (tid == 0) { __builtin_amdgcn_fence(__ATOMIC_ACQUIRE, "agent"); asm volatile("s_waitcnt vmcnt(0)" ::: "memory"); } \
            __syncthreads(); \
        } else { xcd_barrier(xbar); } } } while (0)

    if (IN(0)) REP(0) { if (blk == 0) for (int i = tid; i < (int)(BAR_BYTES / 4); i += NTHR) ((unsigned*)(ws + WS_BAR))[i] = 0u;
        phase0(args.in, ws, lds, tid, lane, wave); }
    SEAM(0);
    if (lo == 0 && hi > 1) xbar = xcd_barrier_post((unsigned*)(ws + WS_BAR), bst);
    if (IN(1)) REP(1) {
        for (int row = gw; row < MROWS; row += NGW) {
            const float* src = row < NLAT ? x + (size_t)row * DM : ctx + (size_t)(row - NLAT) * DM; const int v = row < NLAT ? row / TT : 2;
            norm_mod_row(src, args.in[6], MOD + v * NMODV, MOD + v * NMODV + DM, H + (size_t)row * DM, lane);
        }
    }
    SEAM(1);
    if (IN(2)) REP(2) {
        pg8::Gemm g{H, (const bf16*)(ws + WS_WIN), MROWS, INC, DM}; pg8::StaticOrder S; S.init(MROWS, INC, G, blk);
        pg8::EpiBf16<0> E{P, INC, nullptr, 0, 0, 1.f};
        pg8::gemm_phase<pg8::EpiBf16<0>, pg8::StaticOrder, true, true>(lds, g, S, E);
        { const int nwg = (MROWS / 256) * (INC / 256), nfull = nwg % G;
          const int first = nfull != 0 ? nfull : 0;
          if (blk >= first) convert_weights(6, args.in, ws, lds, (blk - first) * NWAVES + wave, (G - first) * NWAVES, lane, wave); }
    }
    SEAM(2);
    if (IN(3)) REP(3) { scan_prep(P, args.in[9], ws, args.out, lds, tid, lane, wave); }
    SEAM(3);
    if (IN(4)) REP(4) {
        if (G > NSCAN) { if (blk < NSCAN) {
                             REP(40) scan_apply(blk, ws, args.out, OF, OB, lds, tid, lane, wave); }
                         else {
                             REP(41) for (int u = blk - NSCAN; u < 256; u += G - NSCAN) attn_unit(u, P, args.in[11], args.in[12], args.in[13], RC, RS, MIX, lds, tid, lane, wave); }
                         { const int na = G - NSCAN, first1 = 256 - na > 0 ? 256 - na : 0;
                           if (blk >= NSCAN + first1) { __syncthreads(); convert_weights(8, args.in, ws, lds, (blk - NSCAN - first1) * NWAVES + wave, (na - first1) * NWAVES, lane, wave); } } }
        else { for (int it = blk; it < NSCAN; it += G) scan_apply(it, ws, args.out, OF, OB, lds, tid, lane, wave);
               for (int u = blk; u < 256; u += G) attn_unit(u, P, args.in[11], args.in[12], args.in[13], RC, RS, MIX, lds, tid, lane, wave); }
    }
    SEAM(4);
    if (IN(5)) REP(5) { for (int row = gw; row < NLAT; row += NGW) readout_row(row, OF, OB, P, args.in[10], MIX, lane); }
    SEAM(5);
    if (IN(6)) REP(6) {
        pg8::Gemm g{MIX, (const bf16*)(ws + WS_WOUT), NLAT, DM, DM}; pg8::StaticOrder S; S.init(NLAT, DM, G, blk);
        EpiResGate E{x, args.out, MOD + 2 * DM};
        pg8::gemm_phase<EpiResGate, pg8::StaticOrder, true, true>(lds, g, S, E);
    }
    SEAM(6);
    if (IN(7)) REP(7) {
        for (int row = gw; row < NLAT; row += NGW) { const int v = row / TT;
            norm_mod_row(args.out + (size_t)row * DM, args.in[7], MOD + v * NMODV + 3 * DM, MOD + v * NMODV + 4 * DM, H + (size_t)row * DM, lane); }
    }
    SEAM(7);
    if (IN(8)) REP(8) {
        pg8::Gemm g{H, (const bf16*)(ws + WS_WGU), NLAT, 2 * DFF, DM}; pg8::StaticOrder S; S.init(NLAT, 2 * DFF, G, blk);
        EpiSwiGLU E{ACT};
        pg8::gemm_phase<EpiSwiGLU, pg8::StaticOrder, true, true>(lds, g, S, E);
    }
    SEAM(8);
    if (IN(9)) REP(9) {
        pg8::Gemm g{ACT, (const bf16*)(ws + WS_WDN), NLAT, DM, DFF}; pg8::StaticOrder S; S.init(NLAT, DM, G, blk);
        EpiResGate E{args.out, args.out, MOD + 5 * DM};
        pg8::gemm_phase<EpiResGate, pg8::StaticOrder, true, true>(lds, g, S, E);
    }
#undef IN
#undef SEAM
}

extern "C" void kernel_launch(void* const* d_in, const int* in_sizes, int n_in, void* d_out, int out_size, void* d_ws, size_t ws_size, hipStream_t stream) {
    static int grid = 0;
    if (grid == 0) {
        if (n_in != 17 || ws_size < WS_END) { fprintf(stderr, "kernel_launch: unexpected n_in %d or ws_size %zu\n", n_in, ws_size); grid = -1; return; }
        int dev = 0, cus = 0, per_cu = 0;
        hipGetDevice(&dev); hipDeviceGetAttribute(&cus, hipDeviceAttributeMultiprocessorCount, dev);
        if (hipFuncSetAttribute((const void*)fwd_megakernel, hipFuncAttributeMaxDynamicSharedMemorySize, LDS_BYTES) != hipSuccess) { fprintf(stderr, "hipFuncSetAttribute failed\n"); grid = -1; return; }
        if (hipOccupancyMaxActiveBlocksPerMultiprocessor(&per_cu, (const void*)fwd_megakernel, NTHR, LDS_BYTES) != hipSuccess || per_cu < 1) { fprintf(stderr, "occupancy query failed (%d)\n", per_cu); (void)hipGetLastError(); per_cu = 1; }
        grid = cus * per_cu;
    }
    if (grid < 0) return;
    Args a{};
    for (int i = 0; i < 17; ++i) a.in[i] = (const float*)d_in[i];
    a.out = (float*)d_out; a.ws = (unsigned char*)d_ws; a.ph_lo = 0; a.ph_hi = 10;
#ifndef N_LAUNCH
#define N_LAUNCH 9
#endif
#if N_LAUNCH == 1
    void* kargs[] = {&a};
    hipError_t e = hipLaunchCooperativeKernel((const void*)fwd_megakernel, dim3(grid), dim3(NTHR), kargs, LDS_BYTES, stream);
    if (e != hipSuccess) fprintf(stderr, "cooperative launch failed: %s (grid %d)\n", hipGetErrorString(e), grid);
#else
    for (int p = 0; p < 10; ++p) { a.ph_lo = p; a.ph_hi = p + 1; hipLaunchKernelGGL(fwd_megakernel, dim3(grid), dim3(NTHR), LDS_BYTES, stream, a); }
#endif
}
```

```cpp
#define N_LAUNCH 1
#include <hip/hip_runtime.h>
#include <hip/hip_cooperative_groups.h>
#include <cstdio>
#include <cstdint>
namespace cg = cooperative_groups;
namespace pg8 {
#define PG8_LAS __attribute__((address_space(3)))
typedef unsigned short bf16_t;
typedef short bf16x8 __attribute__((ext_vector_type(8)));
typedef float f32x4 __attribute__((ext_vector_type(4)));
typedef unsigned u32x4 __attribute__((ext_vector_type(4)));
constexpr int BM = 256, BK = 64, HALF = 128, HTB = HALF * BK * 2  , STAGE_BYTES = 8 * HTB, NXCD = 8, WGM = 8;

__host__ __device__ __forceinline__ int lds_byte(int r, int c) { const int st = (r >> 4) * 2 + (c >> 5), rr = r & 15, cc = c & 31, ob = rr * 64 + cc * 2; return st * 1024 + (ob ^ (((ob >> 9) & 1) << 5)); }
__host__ __device__ __forceinline__ void stage_rc(int b, int& R, int& C) { const int st = b / 1024, sb = b % 1024, swz = sb ^ (((sb >> 9) & 1) << 5); R = (st >> 1) * 16 + swz / 64; C = (st & 1) * 32 + (swz % 64) / 2; }
__host__ __device__ __forceinline__ int perm32(int rho) { const int n = rho >> 4, i = rho & 15; return 8 * (i >> 2) + 4 * n + (i & 3); }

struct Unit { int pm, pn; };
struct Gemm { const bf16_t* A; const bf16_t* Bt; int M, N, K; };

struct StaticOrder {
    int nM, nN, nwg, G, c;
    __host__ __device__ void init(int M, int N, int G_, int c_) { nM = M / BM; nN = N / BM; nwg = nM * nN; G = G_; c = c_; }
    __host__ __device__ bool next(int i, Unit& u) const {
        const long L = (long)i * G + c; if (L >= nwg) return false;
        int wgid = (int)L; { const int q = nwg / NXCD, r = nwg % NXCD, xcd = wgid % NXCD, off = wgid / NXCD; wgid = (xcd < r ? xcd * (q + 1) : r * (q + 1) + (xcd - r) * q) + off; }
        const int nig = WGM * nN, gid = wgid / nig, fm = gid * WGM, gsz = (nM - fm) < WGM ? (nM - fm) : WGM;
        u.pm = fm + ((wgid % nig) % gsz); u.pn = (wgid % nig) / gsz; return true;
    }
    __device__ __forceinline__ void a_ready(const Unit&) const {}
    __device__ __forceinline__ void done(const Unit&) const {}
};

__device__ __forceinline__ unsigned cvt_pk_bf16(float lo, float hi) { unsigned r; asm volatile("v_cvt_pk_bf16_f32 %0, %1, %2" : "=v"(r) : "v"(lo), "v"(hi)); return r; }
typedef float f32x2 __attribute__((ext_vector_type(2)));
__device__ __forceinline__ f32x2 gelu_pk(f32x2 v) {
    const f32x2 av = __builtin_elementwise_abs(v), d = av * 0.2316418882f + 1.0f;
    f32x2 t; t.x = __builtin_amdgcn_rcpf(d.x); t.y = __builtin_amdgcn_rcpf(d.y);
    f32x2 q = t * 0.5307027145f + (-0.7265760135f); q = q * t + 0.7107068705f; q = q * t + (-0.142248368f); q = q * t + 0.127414796f; q = q * t;
    const f32x2 s = (v * v) * (-0.72134752044f);
    f32x2 e; e.x = __builtin_amdgcn_exp2f(s.x); e.y = __builtin_amdgcn_exp2f(s.y);
    const f32x2 m = v * (q * e), r = v - m;
    f32x2 o; o.x = v.x < 0.f ? m.x : r.x; o.y = v.y < 0.f ? m.y : r.y; return o;
}

template <int ACT  > struct EpiBf16 {
    static constexpr bool PERM = true, AFTER_DRAIN = false; static_assert(ACT == 0 || ACT == 1, "EpiBf16: ACT is 0 (none) or 1 (gelu_pk)");
    bf16_t* O; int ldc; const float* bias; int split_cols; size_t split_stride; float scale0;
    __device__ __forceinline__ void operator()(const f32x4 (&acc)[2][2][4][2], const Unit& u, int wr, int wc, int fr, int fq) const {
        const int row0 = u.pm * BM + wr * 64 + fr; int colt = u.pn * BM; bf16_t* base = O;
        float sc = 1.f; if (split_cols) { const int t = colt / split_cols; base += (size_t)t * split_stride; colt -= t * split_cols; if (t == 0) sc = scale0; }
        const int col0 = colt + wc * 32 + 8 * fq, bcol0 = u.pn * BM + wc * 32 + 8 * fq;
        f32x4 bv[2][2];
#pragma unroll
        for (int bj = 0; bj < 2; ++bj)
#pragma unroll
            for (int n = 0; n < 2; ++n) bv[bj][n] = bias ? *(const f32x4*)(bias + bcol0 + bj * HALF + 4 * n) : (f32x4){0.f, 0.f, 0.f, 0.f};
#pragma unroll
        for (int ai = 0; ai < 2; ++ai)
#pragma unroll
            for (int m = 0; m < 4; ++m) { bf16_t* rowp = base + (size_t)(row0 + ai * HALF + m * 16) * ldc + col0;
#pragma unroll
                for (int bj = 0; bj < 2; ++bj) { f32x4 v0 = acc[ai][bj][m][0] + bv[bj][0], v1 = acc[ai][bj][m][1] + bv[bj][1];
                    if (ACT == 1) { f32x2 a = gelu_pk((f32x2){v0[0], v0[1]}), b = gelu_pk((f32x2){v0[2], v0[3]}), c = gelu_pk((f32x2){v1[0], v1[1]}), d = gelu_pk((f32x2){v1[2], v1[3]});
                        v0 = (f32x4){a.x, a.y, b.x, b.y}; v1 = (f32x4){c.x, c.y, d.x, d.y}; }
                    v0 = v0 * sc; v1 = v1 * sc; u32x4 w; w.x = cvt_pk_bf16(v0[0], v0[1]); w.y = cvt_pk_bf16(v0[2], v0[3]); w.z = cvt_pk_bf16(v1[0], v1[1]); w.w = cvt_pk_bf16(v1[2], v1[3]);
                    *(u32x4*)(rowp + bj * HALF) = w; } }
    }
};

template <class Epi, class Sched, bool ALIGN_EPI = false, bool SP2 = false>
__device__ __forceinline__ void gemm_phase(PG8_LAS unsigned char* lds, const Gemm g, const Sched& S, const Epi& E) {
    const int tid = threadIdx.x, wid = __builtin_amdgcn_readfirstlane(tid >> 6), lane = tid & 63, wr = wid >> 2, wc = wid & 3, fr = lane & 15, fq = lane >> 4;
    const int K = g.K, nt = K / BK;
    unsigned voffA[2], voffB[2];
#pragma unroll
    for (int i = 0; i < 2; ++i) { int R, C; stage_rc(tid * 16 + i * 8192, R, C); const int Rb = Epi::PERM ? ((R & ~31) + perm32(R & 31)) : R;
        voffA[i] = (unsigned)(R * K + C) * 2u; voffB[i] = (unsigned)(Rb * K + C) * 2u; }
    const size_t kstep = (size_t)(BK * 2);
    const size_t hstep = (size_t)HALF * K * 2;
    const size_t tstep = 2 * hstep;
    const unsigned ldsw = (unsigned)wid * 1024u;
    const int aoff = lds_byte(wr * 64 + fr, fq * 8), boff = lds_byte(wc * 32 + fr, fq * 8);
#define PG8_SA(b, h) (((b) * 2 + (h)) * HTB)
#define PG8_SB(b, h) ((4 + (b) * 2 + (h)) * HTB)
#define PG8_STAGE(bufoff, gbase, voff) do { _Pragma("unroll") for (int _i = 0; _i < 2; ++_i) \
        __builtin_amdgcn_global_load_lds((const unsigned*)((const char*)(gbase) + (voff)[_i]), (PG8_LAS unsigned*)(lds + (bufoff) + ldsw + _i * 8192), 16, 0, 0); } while (0)
#define PG8_LDA(dst, b, h) do { _Pragma("unroll") for (int m = 0; m < 4; ++m) _Pragma("unroll") for (int k = 0; k < 2; ++k) dst[m][k] = *(const PG8_LAS bf16x8*)(lds + PG8_SA(b, h) + aoff + m * 2048 + k * 1024); } while (0)
#define PG8_LDB(dst, b, h) do { _Pragma("unroll") for (int n = 0; n < 2; ++n) _Pragma("unroll") for (int k = 0; k < 2; ++k) dst[n][k] = *(const PG8_LAS bf16x8*)(lds + PG8_SB(b, h) + boff + n * 2048 + k * 1024); } while (0)
#define PG8_MMA(ai, bj, At, Bt) do { __builtin_amdgcn_s_setprio(1); _Pragma("unroll") for (int m = 0; m < 4; ++m) _Pragma("unroll") for (int n = 0; n < 2; ++n) _Pragma("unroll") for (int k = 0; k < 2; ++k) \
        acc[ai][bj][m][n] = __builtin_amdgcn_mfma_f32_16x16x32_bf16(Bt[n][k], At[m][k], acc[ai][bj][m][n], 0, 0, 0); __builtin_amdgcn_s_setprio(0); } while (0)
#define PG8_WAIT_V(n) asm volatile("s_waitcnt vmcnt(" #n ")" ::: "memory")
#define PG8_WAIT_L(n) asm volatile("s_waitcnt lgkmcnt(" #n ")" ::: "memory")
#define PG8_BAR __builtin_amdgcn_s_barrier()
#define PG8_SCHED __builtin_amdgcn_sched_barrier(0)
    Unit cur, nxt; int ui = 0;
    if (!S.next(0, cur)) return;
    f32x4 acc[2][2][4][2];
#pragma unroll
    for (int a = 0; a < 2; ++a)
#pragma unroll
        for (int b = 0; b < 2; ++b)
#pragma unroll
            for (int m = 0; m < 4; ++m)
#pragma unroll
                for (int n = 0; n < 2; ++n) acc[a][b][m][n] = (f32x4){0.f, 0.f, 0.f, 0.f};
    bf16x8 At[4][2], B0[2][2], B1[2][2];
    const char* cA = (const char*)g.A + (size_t)cur.pm * tstep; const char* cB = (const char*)g.Bt + (size_t)cur.pn * tstep;
    S.a_ready(cur);
    if constexpr (SP2) {
        PG8_STAGE(PG8_SB(0, 0), cB, voffB); PG8_STAGE(PG8_SB(0, 1), cB + hstep, voffB); PG8_STAGE(PG8_SA(0, 0), cA, voffA); PG8_STAGE(PG8_SA(0, 1), cA + hstep, voffA);
        if (wr == 1) PG8_BAR;
        PG8_WAIT_V(2); PG8_BAR;
        PG8_STAGE(PG8_SB(1, 0), cB + kstep, voffB); PG8_STAGE(PG8_SA(1, 0), cA + kstep, voffA); PG8_STAGE(PG8_SB(1, 1), cB + hstep + kstep, voffB);
        PG8_WAIT_V(6); PG8_BAR;
    } else {
        PG8_STAGE(PG8_SB(0, 0), cB, voffB); PG8_STAGE(PG8_SA(0, 0), cA, voffA); PG8_STAGE(PG8_SB(0, 1), cB + hstep, voffB); PG8_STAGE(PG8_SA(0, 1), cA + hstep, voffA);
        if (wr == 1) PG8_BAR;
        PG8_WAIT_V(4); PG8_BAR;
        PG8_STAGE(PG8_SB(1, 0), cB + kstep, voffB); PG8_STAGE(PG8_SA(1, 0), cA + kstep, voffA); PG8_STAGE(PG8_SB(1, 1), cB + hstep + kstep, voffB);
        PG8_WAIT_V(6); PG8_BAR;
    }
    for (;;) {
        const bool has_next = S.next(ui + 1, nxt);
        const char* nA = has_next ? (const char*)g.A + (size_t)nxt.pm * tstep : cA; const char* nB = has_next ? (const char*)g.Bt + (size_t)nxt.pn * tstep : cB;
        for (int t = 0; t < nt; t += 2) {
            const bool last = (t == nt - 2);
            const char* a1 = cA + (size_t)(t + 1) * kstep;
            const char* a2 = last ? nA : cA + (size_t)(t + 2) * kstep; const char* b2 = last ? nB : cB + (size_t)(t + 2) * kstep;
            const char* a3 = a2 + kstep; const char* b3 = b2 + kstep;
            if (last && has_next) S.a_ready(nxt);
            if constexpr (SP2) {
            PG8_LDB(B0, 0, 0); PG8_LDB(B1, 0, 1); PG8_SCHED; PG8_LDA(At, 0, 0); PG8_STAGE(PG8_SA(1, 1), a1 + hstep, voffA);
            PG8_WAIT_V(8); PG8_WAIT_L(0); PG8_BAR; PG8_MMA(0, 0, At, B0); PG8_MMA(0, 1, At, B1); PG8_BAR; PG8_SCHED;
            PG8_LDA(At, 0, 1); PG8_STAGE(PG8_SB(0, 0), b2, voffB); PG8_STAGE(PG8_SB(0, 1), b2 + hstep, voffB); PG8_STAGE(PG8_SA(0, 0), a2, voffA);
            PG8_WAIT_V(8); PG8_WAIT_L(0); PG8_BAR; PG8_MMA(1, 0, At, B0); PG8_MMA(1, 1, At, B1); PG8_BAR; PG8_SCHED;
            PG8_LDB(B0, 1, 0); PG8_LDB(B1, 1, 1); PG8_SCHED; PG8_LDA(At, 1, 0); PG8_STAGE(PG8_SA(0, 1), a2 + hstep, voffA);
            PG8_WAIT_V(8); PG8_WAIT_L(0); PG8_BAR; PG8_MMA(0, 0, At, B0); PG8_MMA(0, 1, At, B1); PG8_BAR; PG8_SCHED;
            PG8_LDA(At, 1, 1); PG8_STAGE(PG8_SB(1, 0), b3, voffB); PG8_STAGE(PG8_SB(1, 1), b3 + hstep, voffB); PG8_STAGE(PG8_SA(1, 0), a3, voffA);
            PG8_WAIT_V(8); PG8_WAIT_L(0); PG8_BAR; PG8_MMA(1, 0, At, B0); PG8_MMA(1, 1, At, B1); PG8_BAR; PG8_SCHED;
            } else {
            PG8_LDB(B0, 0, 0); PG8_SCHED; PG8_LDA(At, 0, 0); PG8_STAGE(PG8_SA(1, 1), a1 + hstep, voffA);
            PG8_WAIT_L(8); PG8_BAR; PG8_WAIT_L(0); PG8_MMA(0, 0, At, B0); PG8_BAR; PG8_SCHED;
            PG8_LDB(B1, 0, 1); PG8_STAGE(PG8_SB(0, 0), b2, voffB);
            PG8_BAR; PG8_WAIT_L(0); PG8_MMA(0, 1, At, B1); PG8_BAR;
            PG8_LDA(At, 0, 1); PG8_STAGE(PG8_SA(0, 0), a2, voffA);
            PG8_BAR; PG8_WAIT_L(0); PG8_MMA(1, 0, At, B0); PG8_BAR; PG8_SCHED;
            PG8_STAGE(PG8_SB(0, 1), b2 + hstep, voffB);
            PG8_WAIT_V(6); PG8_BAR; PG8_MMA(1, 1, At, B1); PG8_BAR;
            PG8_LDB(B0, 1, 0); PG8_SCHED; PG8_LDA(At, 1, 0); PG8_STAGE(PG8_SA(0, 1), a2 + hstep, voffA);
            PG8_WAIT_L(8); PG8_BAR; PG8_WAIT_L(0); PG8_MMA(0, 0, At, B0); PG8_BAR; PG8_SCHED;
            PG8_LDB(B1, 1, 1); PG8_STAGE(PG8_SB(1, 0), b3, voffB);
            PG8_BAR; PG8_WAIT_L(0); PG8_MMA(0, 1, At, B1); PG8_BAR;
            PG8_LDA(At, 1, 1); PG8_STAGE(PG8_SA(1, 0), a3, voffA);
            PG8_BAR; PG8_WAIT_L(0); PG8_MMA(1, 0, At, B0); PG8_BAR; PG8_SCHED;
            PG8_STAGE(PG8_SB(1, 1), b3 + hstep, voffB);
            PG8_WAIT_V(6); PG8_BAR; PG8_MMA(1, 1, At, B1); PG8_BAR;
            }
        }
        if constexpr (ALIGN_EPI) { if (wr == 0) PG8_BAR; }
        if constexpr (!Epi::AFTER_DRAIN) { E(acc, cur, wr, wc, fr, fq); S.done(cur); }
        if (!has_next) break;
#pragma unroll
        for (int a = 0; a < 2; ++a)
#pragma unroll
            for (int b = 0; b < 2; ++b)
#pragma unroll
                for (int m = 0; m < 4; ++m)
#pragma unroll
                    for (int n = 0; n < 2; ++n) acc[a][b][m][n] = (f32x4){0.f, 0.f, 0.f, 0.f};
        cur = nxt; cA = nA; cB = nB; ++ui;
        if constexpr (ALIGN_EPI) { if (wr == 1) PG8_BAR; }
    }
    PG8_WAIT_V(0);
    if constexpr (!ALIGN_EPI) { if (wr == 0) PG8_BAR; }
    PG8_BAR;
    if constexpr (Epi::AFTER_DRAIN) { E.fused(acc, cur, wr, wc, fr, fq, lds, wid, lane); S.done(cur); }
#undef PG8_SA
#undef PG8_SB
#undef PG8_STAGE
#undef PG8_LDA
#undef PG8_LDB
#undef PG8_MMA
#undef PG8_WAIT_V
#undef PG8_WAIT_L
#undef PG8_BAR
#undef PG8_SCHED
}
}

#define LAS __attribute__((address_space(3)))
typedef unsigned short bf16;
typedef pg8::f32x4 f32x4;
typedef pg8::bf16x8 bf16x8;
typedef pg8::u32x4 u32x4;
typedef unsigned u32x2 __attribute__((ext_vector_type(2)));

constexpr int DM = 2048, TT = 4096, NB = 2, LC = 256;
constexpr int NLAT = NB * TT, NCTX = NB * LC, MROWS = NLAT + NCTX;
constexpr int INC = 6656, DFF = 5632, NMODV = 12288;
constexpr int C_Q = 0, C_FF = 1024, C_FB = 2048, C_I = 3072, C_G = 4096, C_AQ = 5120, C_AK = 6144, C_AV = 6400;
constexpr float RMS_EPS = 1e-6f;
constexpr int NTHR = 512, NWAVES = 8;
constexpr int NSCAN = 64;

constexpr size_t MiB = 1u << 20;
constexpr size_t WS_MOD = 0, WS_ROPE = 256 * 1024;
constexpr size_t WS_WOUT = 1 * MiB, WS_WGU = 9 * MiB, WS_WDN = 53 * MiB, WS_WIN = 75 * MiB;
constexpr size_t WS_REC0 = 75 * MiB;
constexpr size_t WS_H = 101 * MiB, WS_P = 135 * MiB, WS_ACT = WS_P, WS_OF = 246 * MiB, WS_OB = 278 * MiB, WS_MIX = 310 * MiB, WS_END = 352 * MiB;
constexpr int LDS_BYTES = 151552;

__device__ __forceinline__ float bf2f(unsigned short u) { return __uint_as_float(((unsigned)u) << 16); }
typedef float f32x2_t __attribute__((ext_vector_type(2)));
typedef __bf16 bf16x2_t __attribute__((ext_vector_type(2)));
__device__ __forceinline__ unsigned pk2(float lo, float hi) { const f32x2_t v = {lo, hi}; const bf16x2_t b = __builtin_convertvector(v, bf16x2_t); return __builtin_bit_cast(unsigned, b); }
__device__ __forceinline__ unsigned short f2bf(float x) { const __bf16 b = (__bf16)x; return __builtin_bit_cast(unsigned short, b); }
__device__ __forceinline__ float wave_sum(float v) {
#pragma unroll
    for (int o = 1; o < 64; o <<= 1) v += __shfl_xor(v, o);
    return v;
}
__device__ __forceinline__ float sigmoidf_(float x) { return 1.f / (1.f + __expf(-x)); }
__device__ __forceinline__ float siluf_(float x) { return x / (1.f + __expf(-x)); }

__device__ __forceinline__ void transpose_item(const float* W, int K, int N, bf16* WT, int k0, int n0, int drow, LAS float* scr, int lane) {
    const int kq = lane >> 4, nx = lane & 15;
#pragma unroll 1
    for (int hb = 0; hb < 2; ++hb) {
        f32x4 v[8];
#pragma unroll
        for (int i = 0; i < 8; ++i) v[i] = *(const f32x4*)(W + (size_t)(k0 + 32 * hb + 4 * i + kq) * N + n0 + 4 * nx);
#pragma unroll
        for (int i = 0; i < 8; ++i) { LAS float* d = scr + (4 * nx) * 65 + 32 * hb + 4 * i + kq; d[0] = v[i].x; d[65] = v[i].y; d[130] = v[i].z; d[195] = v[i].w; }
    }
    asm volatile("s_waitcnt lgkmcnt(0)" ::: "memory");
    const int c = lane & 7;
#pragma unroll
    for (int j = 0; j < 8; ++j) { const int n = (lane >> 3) + 8 * j; const LAS float* s = scr + n * 65 + 8 * c;
        u32x4 o; o.x = pk2(s[0], s[1]); o.y = pk2(s[2], s[3]); o.z = pk2(s[4], s[5]); o.w = pk2(s[6], s[7]);
        *(u32x4*)(WT + (size_t)(drow + n) * K + k0 + 8 * c) = o; }
    asm volatile("s_waitcnt lgkmcnt(0)" ::: "memory");
}

__device__ __forceinline__ void convert_weights(int mask, const float* const* in, unsigned char* ws, LAS unsigned char* lds, int w, int nw, int lane, int wave) {
    LAS float* scr = (LAS float*)(lds + wave * 16640);
    const int cnt0 = (mask & 1) ? (DM / 64) * (INC / 64) : 0, cnt1 = (mask & 2) ? (DM / 64) * (DM / 64) : 0, cnt2 = (mask & 4) ? (DFF / 64) * (DM / 64) : 0, cnt3 = (mask & 8) ? (DM / 64) * (2 * DFF / 64) : 0;
#pragma unroll 1
    for (int it = w; it < cnt0 + cnt1 + cnt2 + cnt3; it += nw) {
        int r = it, m = 0;
        if (r >= cnt0) { r -= cnt0; m = 1; if (r >= cnt1) { r -= cnt1; m = 2; if (r >= cnt2) { r -= cnt2; m = 3; } } }
        const float* W = m == 0 ? in[8] : (m == 1 ? in[14] : (m == 2 ? in[16] : in[15]));
        const int K = m == 2 ? DFF : DM, N = m == 0 ? INC : (m == 3 ? 2 * DFF : DM);
        bf16* WT = (bf16*)(ws + (m == 0 ? WS_WIN : (m == 1 ? WS_WOUT : (m == 2 ? WS_WDN : WS_WGU))));
        const int nblk = N / 64, kb = r / nblk, nb = r % nblk, n0 = 64 * nb;
        int drow = n0;
        if (m == 3) { const int half = n0 / DFF, j = n0 % DFF; drow = 256 * (j / 128) + 128 * half + (j % 128); }
        transpose_item(W, K, N, WT, 64 * kb, n0, drow, scr, lane);
    }
}

__device__ __forceinline__ void mod_item(int item, const float* c, const float* c_ctx, const float* w_mod, const float* b_mod, float* MOD, LAS float* L, int tid) {
    LAS float* sv = L;
    LAS float* red = L + 6144;
    for (int i = tid; i < 3 * DM; i += NTHR) { const int v = i / DM, k = i % DM; const float x = v < 2 ? c[v * DM + k] : c_ctx[k]; sv[i] = siluf_(x); }
    __syncthreads();
    const int cl = tid & 15, rl = tid >> 4, col = item * 64 + cl * 4;
    f32x4 a0 = {0.f, 0.f, 0.f, 0.f}, a1 = a0, a2 = a0;
#pragma unroll 8
    for (int k = rl; k < DM; k += 32) { const f32x4 w = *(const f32x4*)(w_mod + (size_t)k * NMODV + col); a0 += w * sv[k]; a1 += w * sv[DM + k]; a2 += w * sv[2 * DM + k]; }
    LAS float* r = red + tid * 12;
    r[0] = a0.x; r[1] = a0.y; r[2] = a0.z; r[3] = a0.w; r[4] = a1.x; r[5] = a1.y; r[6] = a1.z; r[7] = a1.w; r[8] = a2.x; r[9] = a2.y; r[10] = a2.z; r[11] = a2.w;
    __syncthreads();
    if (tid < 16 * 12) { const int cl2 = tid / 12, e = tid % 12; float s = 0.f;
        for (int q = 0; q < 32; ++q) s += red[(q * 16 + cl2) * 12 + e];
        const int v = e >> 2, cc = item * 64 + cl2 * 4 + (e & 3); MOD[v * NMODV + cc] = s + b_mod[cc]; }
    __syncthreads();
}

__device__ __forceinline__ void phase0(const float* const* in, unsigned char* ws, LAS unsigned char* lds, int tid, int lane, int wave) {
    const int blk = blockIdx.x, G = gridDim.x;
    float* MOD = (float*)(ws + WS_MOD);
    __syncthreads();
    for (int item = blk; item < NMODV / 64; item += G) mod_item(item, in[1], in[3], in[4], in[5], MOD, (LAS float*)lds, tid);
    if (blk == G - 1) {
        float* RC = (float*)(ws + WS_ROPE); float* RS = RC + 2048;
        for (int i = tid; i < 2048; i += NTHR) { const int pos = i >> 5, f = i & 31; const double inv = pow(10000.0, -(double)f / 32.0); const float ang = (float)pos * (float)inv;
            RC[i] = (float)cos((double)ang); RS[i] = (float)sin((double)ang); }
    }
    convert_weights(G > NSCAN ? 1 : 9, in, ws, lds, blk * NWAVES + wave, G * NWAVES, lane, wave);
}

__device__ __forceinline__ void norm_mod_row(const float* src, const float* gamma, const float* shift, const float* scale, bf16* dst, int lane) {
    const f32x4* xr = (const f32x4*)src + lane;
    f32x4 v[8]; float ss = 0.f;
#pragma unroll
    for (int j = 0; j < 8; ++j) { v[j] = xr[64 * j]; ss += (v[j].x * v[j].x + v[j].y * v[j].y) + (v[j].z * v[j].z + v[j].w * v[j].w); }
    const float rstd = rsqrtf(wave_sum(ss) * (1.f / DM) + RMS_EPS);
    u32x2* o = (u32x2*)dst + lane;
#pragma unroll
    for (int j = 0; j < 8; ++j) {
        const f32x4 g = ((const f32x4*)gamma)[lane + 64 * j], sh = ((const f32x4*)shift)[lane + 64 * j], sc = ((const f32x4*)scale)[lane + 64 * j];
        const f32x4 y = v[j] * rstd * g; const f32x4 h = y * (sc + 1.f) + sh;
        u32x2 w; w.x = pk2(h.x, h.y); w.y = pk2(h.z, h.w); o[64 * j] = w;
    }
}

struct EpiResGate {
    static constexpr bool PERM = false, AFTER_DRAIN = false;
    const float* base; float* out; const float* gate;
    __device__ __forceinline__ void operator()(const f32x4 (&acc)[2][2][4][2], const pg8::Unit& u, int wr, int wc, int fr, int fq) const {
        const int row0 = u.pm * 256 + wr * 64 + fr, col0 = u.pn * 256 + wc * 32 + 4 * fq;
        const float* gv = gate + (size_t)(u.pm / 16) * NMODV;
#pragma unroll
        for (int bj = 0; bj < 2; ++bj)
#pragma unroll
            for (int n = 0; n < 2; ++n) { const int col = col0 + bj * 128 + n * 16; const f32x4 g = *(const f32x4*)(gv + col);
#pragma unroll
                for (int ai = 0; ai < 2; ++ai)
#pragma unroll
                    for (int m = 0; m < 4; ++m) { const size_t off = (size_t)(row0 + ai * 128 + m * 16) * DM + col;
                        const f32x4 b = *(const f32x4*)(base + off); *(f32x4*)(out + off) = b + g * acc[ai][bj][m][n]; } }
    }
};
struct EpiSwiGLU {
    static constexpr bool PERM = true, AFTER_DRAIN = false;
    bf16* O;
    __device__ __forceinline__ void operator()(const f32x4 (&acc)[2][2][4][2], const pg8::Unit& u, int wr, int wc, int fr, int fq) const {
        const int row0 = u.pm * 256 + wr * 64 + fr, col0 = u.pn * 128 + wc * 32 + 8 * fq;
#pragma unroll
        for (int ai = 0; ai < 2; ++ai)
#pragma unroll
            for (int m = 0; m < 4; ++m) {
                const f32x4 g0 = acc[ai][0][m][0], g1 = acc[ai][0][m][1], u0 = acc[ai][1][m][0], u1 = acc[ai][1][m][1];
                u32x4 w; w.x = pk2(siluf_(g0.x) * u0.x, siluf_(g0.y) * u0.y); w.y = pk2(siluf_(g0.z) * u0.z, siluf_(g0.w) * u0.w);
                w.z = pk2(siluf_(g1.x) * u1.x, siluf_(g1.y) * u1.y); w.w = pk2(siluf_(g1.z) * u1.z, siluf_(g1.w) * u1.w);
                *(u32x4*)(O + (size_t)(row0 + ai * 128 + m * 16) * DFF + col0) = w; }
    }
};


#define MFMA16(a, b, c) __builtin_amdgcn_mfma_f32_16x16x32_bf16((a), (b), (c), 0, 0, 0)
constexpr int SQ_STR = 136;

constexpr int REC_BYTES = 27648, R_QD = 0, R_KRT = 8704, R_VT = 16896, R_SC = 25088, R_DK = 27136;
constexpr int NCHUNK = 136, NITEMS_A = 32 * NCHUNK;
__device__ __forceinline__ unsigned char* rec_ptr(unsigned char* ws, float* dout, int b, int h, int dir, int n) {
    unsigned char* base = dir ? (unsigned char*)dout : ws + WS_REC0; return base + (size_t)((b * 8 + h) * NCHUNK + n) * REC_BYTES; }
__device__ __forceinline__ size_t scan_row(int b, int dir, int n, int s) {
    if (n < 8) { const int p = 32 * n + s; return (size_t)(NLAT + b * LC + (dir ? (LC - 1 - p) : p)); }
    const int p = 32 * (n - 8) + s; return (size_t)(b * TT + (dir ? (TT - 1 - p) : p)); }

__device__ __forceinline__ void scan_prep(const bf16* P, const float* hg_lb, unsigned char* ws, float* dout, LAS unsigned char* lds, int tid, int lane, int wave) {
    LAS bf16* QD = (LAS bf16*)(lds); LAS bf16* KI = (LAS bf16*)(lds + 8704); LAS float* TOT = (LAS float*)(lds + 17408);
    const int k = tid & 127, sg = tid >> 7, fr = lane & 15, quad = lane >> 4, G = gridDim.x;
    const int kp = (k & ~31) | (8 * ((k >> 2) & 3) + 4 * ((k >> 4) & 1) + (k & 3));
    unsigned short rq[8], rf[8], rv[8];
    int it = blockIdx.x;
    if (it < NITEMS_A) { const int n = it % NCHUNK, bhd = it / NCHUNK, dir = bhd & 1, h = (bhd >> 1) & 7, b = bhd >> 4;
#pragma unroll
        for (int j = 0; j < 8; ++j) { const bf16* pr = P + scan_row(b, dir, n, 8 * sg + j) * INC + h * 128 + k; rq[j] = pr[C_Q]; rf[j] = pr[dir ? C_FB : C_FF]; rv[j] = pr[C_I]; } }
    __syncthreads();
    for (; it < NITEMS_A; it += G) {
        const int n = it % NCHUNK, bhd = it / NCHUNK, dir = bhd & 1, h = (bhd >> 1) & 7, b = bhd >> 4;
        unsigned char* rec = rec_ptr(ws, dout, b, h, dir, n);
        const float lb = 1.f / (1.f + __expf(hg_lb[2048 + dir * 1024 + h * 128 + k] - hg_lb[dir * 1024 + h * 128 + k]));
        float lf[8], kk[8], qv[8]; unsigned short vv[8]; float cs = 0.f;
#pragma unroll
        for (int j = 0; j < 8; ++j) { const float fp = bf2f(rf[j]); const float ef = __expf(-fp), sgm = __builtin_amdgcn_rcpf(1.f + ef);
            const float f = lb + (1.f - lb) * sgm; kk[j] = (1.f - lb) * ef * sgm;
            cs += __logf(f); lf[j] = cs; const float qp = bf2f(rq[j]); qv[j] = qp * __builtin_amdgcn_rcpf(1.f + __expf(-qp)); vv[j] = rv[j]; }
        { const int it2 = it + G;
          if (it2 < NITEMS_A) { const int n2 = it2 % NCHUNK, bhd2 = it2 / NCHUNK, dir2 = bhd2 & 1, h2 = (bhd2 >> 1) & 7, b2 = bhd2 >> 4;
#pragma unroll
            for (int j = 0; j < 8; ++j) { const bf16* pr = P + scan_row(b2, dir2, n2, 8 * sg + j) * INC + h2 * 128 + k; rq[j] = pr[C_Q]; rf[j] = pr[dir2 ? C_FB : C_FF]; rv[j] = pr[C_I]; } } }
        TOT[sg * 128 + k] = cs;
        __syncthreads();
        const float t0 = TOT[k], t1 = TOT[128 + k], t2 = TOT[256 + k], t3 = TOT[384 + k];
        const float off = sg == 0 ? 0.f : (sg == 1 ? t0 : (sg == 2 ? t0 + t1 : t0 + t1 + t2)), blast = (t0 + t1) + (t2 + t3);
        unsigned krp[4];
        const float eb = __expf(blast);
#pragma unroll
        for (int j = 0; j < 8; j += 2) {
            const float b0 = off + lf[j], b1 = off + lf[j + 1];
            const float e0 = __expf(b0), e1 = __expf(b1), i0 = __builtin_amdgcn_rcpf(e0), i1 = __builtin_amdgcn_rcpf(e1);
            if (n >= 8) {
                const unsigned short q0 = f2bf(qv[j] * e0), q1 = f2bf(qv[j + 1] * e1);
                QD[(8 * sg + j) * SQ_STR + kp] = q0; QD[(8 * sg + j + 1) * SQ_STR + kp] = q1;
                ((bf16*)(rec + R_QD))[(8 * sg + j) * SQ_STR + kp] = q0; ((bf16*)(rec + R_QD))[(8 * sg + j + 1) * SQ_STR + kp] = q1;
                KI[(8 * sg + j) * SQ_STR + kp] = f2bf(kk[j] * i0); KI[(8 * sg + j + 1) * SQ_STR + kp] = f2bf(kk[j + 1] * i1);
            }
            krp[j >> 1] = pk2(kk[j] * (eb * i0), kk[j + 1] * (eb * i1));
        }
        *(u32x4*)(rec + R_KRT + k * 64 + ((sg ^ ((k >> 2) & 3)) * 16)) = (u32x4){krp[0], krp[1], krp[2], krp[3]};
        *(u32x4*)(rec + R_VT + k * 64 + ((sg ^ ((k >> 2) & 3)) * 16)) = (u32x4){(unsigned)vv[0] | ((unsigned)vv[1] << 16), (unsigned)vv[2] | ((unsigned)vv[3] << 16), (unsigned)vv[4] | ((unsigned)vv[5] << 16), (unsigned)vv[6] | ((unsigned)vv[7] << 16)};
        if (sg == 0) ((float*)(rec + R_DK))[k] = eb;
        __syncthreads();
        if (n >= 8 && wave < 4) {
            const int ct = wave >> 1, st = wave & 1; f32x4 a = {0.f, 0.f, 0.f, 0.f};
#pragma unroll
            for (int ks = 0; ks < 4; ++ks) { const bf16x8 af = *(const LAS bf16x8*)(QD + (16 * ct + fr) * SQ_STR + 32 * ks + 8 * quad); const bf16x8 bfr = *(const LAS bf16x8*)(KI + (16 * st + fr) * SQ_STR + 32 * ks + 8 * quad);
                a = MFMA16(af, bfr, a); }
#pragma unroll
            for (int r = 0; r < 4; ++r) { const int c = 16 * ct + 4 * quad + r, s2 = 16 * st + fr; ((bf16*)(rec + R_SC))[c * 32 + ((((s2 >> 3) ^ ((c >> 2) & 3))) << 3) + (s2 & 7)] = f2bf(s2 <= c ? a[r] : 0.f); }
        }
    }
    __syncthreads();
}

__device__ __forceinline__ void scan_apply(int item, unsigned char* ws, float* dout, float* OF, float* OB, LAS unsigned char* lds, int tid, int lane, int wave) {
    const int vh = item & 1, dir = (item >> 1) & 1, h = (item >> 2) & 7, b = item >> 5, fr = lane & 15, quad = lane >> 4;
    float* OUT = dir ? OB : OF;
    const unsigned char* rec0 = rec_ptr(ws, dout, b, h, dir, 0);
    const int swz = quad ^ ((fr >> 2) & 3);
    const bool active = wave < 4;
    const int vtile = 4 * vh + (wave & 3);
    f32x4 Sacc[8];
#pragma unroll
    for (int kt = 0; kt < 8; ++kt) Sacc[kt] = (f32x4){0.f, 0.f, 0.f, 0.f};
    constexpr int NSLOT = 6, SLOT_BYTES = 24576;
    const int vsh = vh ? 3072 : 0;
    const int npre = vh ? 17 : 21;
#define SA_STAGE(chunk) do { const int _c = (chunk) < NCHUNK ? (chunk) : NCHUNK - 1; const unsigned char* _g = rec0 + (size_t)_c * REC_BYTES + lane * 16; LAS unsigned char* _l = lds + ((chunk) % NSLOT) * SLOT_BYTES; \
        _Pragma("unroll") for (int _i = 0; _i < 6; ++_i) { const int _j = (wave - 4) * 6 + _i; const int _p = _j < npre ? _j : _j + 3;     \
            __builtin_amdgcn_global_load_lds((const unsigned*)(_g + _p * 1024), (LAS unsigned*)(_l + _j * 1024), 16, 0, 0); } } while (0)
    __syncthreads();
    if (!active) { SA_STAGE(0); SA_STAGE(1); SA_STAGE(2); SA_STAGE(3); SA_STAGE(4); }
    const long rstep = dir ? -1024 : 1024;
#define SA_HEAD(n) do { if (!active) asm volatile("s_waitcnt vmcnt(24)" ::: "memory");     \
        __builtin_amdgcn_s_barrier(); asm volatile("" ::: "memory"); \
        if (!active) SA_STAGE((n) + 5);                                } while (0)
    for (int n = 0; n < 8; ++n) {
        SA_HEAD(n);
        if (active) {
            const LAS unsigned char* slot = lds + (n % NSLOT) * SLOT_BYTES;
            const bf16x8 vfr = *(const LAS bf16x8*)(slot + R_VT - vsh + (16 * vtile + fr) * 64 + swz * 16);
#pragma unroll
            for (int kt = 0; kt < 8; ++kt) {
                const f32x4 d = *(const LAS f32x4*)(slot + (R_DK - 3072) + (16 * kt + 4 * quad) * 4);
                const bf16x8 af = *(const LAS bf16x8*)(slot + R_KRT + (16 * kt + fr) * 64 + swz * 16);
                Sacc[kt] = MFMA16(af, vfr, Sacc[kt] * d);
            }
        }
    }
    for (int n = 8; n < NCHUNK; ++n) {
        SA_HEAD(n);
        if (active) {
            const LAS unsigned char* slot = lds + (n % NSLOT) * SLOT_BYTES;
            const bf16x8 vfr = *(const LAS bf16x8*)(slot + R_VT - vsh + (16 * vtile + fr) * 64 + swz * 16);
            bf16x8 sb[4];
#pragma unroll
            for (int ks = 0; ks < 4; ++ks) sb[ks] = __builtin_bit_cast(bf16x8, (u32x4){pk2(Sacc[2 * ks].x, Sacc[2 * ks].y), pk2(Sacc[2 * ks].z, Sacc[2 * ks].w), pk2(Sacc[2 * ks + 1].x, Sacc[2 * ks + 1].y), pk2(Sacc[2 * ks + 1].z, Sacc[2 * ks + 1].w)});
            float* op = OUT + scan_row(b, dir, n, 4 * quad) * 1024 + h * 128 + 16 * vtile + fr;
            f32x4 o0 = {0.f, 0.f, 0.f, 0.f}, o1 = o0;
            { const bf16x8 a0 = *(const LAS bf16x8*)(slot + (R_SC - 3072) + (fr) * 64 + swz * 16), a1 = *(const LAS bf16x8*)(slot + (R_SC - 3072) + (16 + fr) * 64 + swz * 16); o0 = MFMA16(a0, vfr, o0); o1 = MFMA16(a1, vfr, o1); }
#pragma unroll
            for (int ks = 0; ks < 4; ++ks) {
                const bf16x8 a0 = *(const LAS bf16x8*)(slot + R_QD + (fr) * (SQ_STR * 2) + (32 * ks + 8 * quad) * 2), a1 = *(const LAS bf16x8*)(slot + R_QD + (16 + fr) * (SQ_STR * 2) + (32 * ks + 8 * quad) * 2);
                o0 = MFMA16(a0, sb[ks], o0); o1 = MFMA16(a1, sb[ks], o1);
#pragma unroll
                for (int kk2 = 0; kk2 < 2; ++kk2) { const int kt = 2 * ks + kk2;
                    const f32x4 d = *(const LAS f32x4*)(slot + (R_DK - 3072) + (16 * kt + 4 * quad) * 4);
                    const bf16x8 af = *(const LAS bf16x8*)(slot + R_KRT + (16 * kt + fr) * 64 + swz * 16);
                    Sacc[kt] = MFMA16(af, vfr, Sacc[kt] * d); }
            }
#pragma unroll
            for (int r = 0; r < 4; ++r) { op[r * rstep] = o0[r]; op[(16 + r) * rstep] = o1[r]; }
        }
    }
#undef SA_HEAD
    asm volatile("s_waitcnt vmcnt(0)" ::: "memory");
    __syncthreads();
#undef SA_STAGE
}

constexpr int AQ_STR = 136, AV_STR = 72;
constexpr int AT_OFF_Q = 0, AT_OFF_K = 256 * AQ_STR * 2, AT_OFF_VT = AT_OFF_K + 64 * AQ_STR * 2;
__device__ __forceinline__ void rows64_load(const bf16* src0, size_t row_stride, int tid, u32x2 (&raw)[4]) {
    const bf16* src = src0 + (size_t)(tid >> 3) * row_stride + (tid & 7) * 4;
#pragma unroll
    for (int g = 0; g < 4; ++g) raw[g] = *(const u32x2*)(src + 32 * g);
}
__device__ __forceinline__ void rows64_proc(const u32x2 (&raw)[4], int pos0, bool rope, const float* gamma, const float* RC, const float* RS, LAS bf16* dst, int tid, float mul) {
    const int rr = tid >> 3, sub = tid & 7;
    float y[4][4]; float ss = 0.f;
#pragma unroll
    for (int g = 0; g < 4; ++g) { const u32x2 w = raw[g];
        y[g][0] = __uint_as_float(w.x << 16); y[g][1] = __uint_as_float(w.x & 0xffff0000u); y[g][2] = __uint_as_float(w.y << 16); y[g][3] = __uint_as_float(w.y & 0xffff0000u);
        ss += (y[g][0] * y[g][0] + y[g][1] * y[g][1]) + (y[g][2] * y[g][2] + y[g][3] * y[g][3]); }
    ss += __shfl_xor(ss, 1); ss += __shfl_xor(ss, 2); ss += __shfl_xor(ss, 4);
    const float rstd = rsqrtf(ss * (1.f / 128.f) + RMS_EPS) * mul;
#pragma unroll
    for (int g = 0; g < 4; ++g) { const f32x4 gm = *(const f32x4*)(gamma + sub * 4 + 32 * g);
        y[g][0] *= rstd * gm.x; y[g][1] *= rstd * gm.y; y[g][2] *= rstd * gm.z; y[g][3] *= rstd * gm.w; }
    if (rope) {
        const int pos = pos0 + rr, prow = pos >> 6, pcol = pos & 63;
        const f32x4 cr = *(const f32x4*)(RC + prow * 32 + sub * 4), sr = *(const f32x4*)(RS + prow * 32 + sub * 4), cc = *(const f32x4*)(RC + pcol * 32 + sub * 4), sc = *(const f32x4*)(RS + pcol * 32 + sub * 4);
#pragma unroll
        for (int e = 0; e < 4; ++e) { const float a = y[0][e], bb = y[1][e]; y[0][e] = a * cr[e] - bb * sr[e]; y[1][e] = a * sr[e] + bb * cr[e];
            const float a2 = y[2][e], b2 = y[3][e]; y[2][e] = a2 * cc[e] - b2 * sc[e]; y[3][e] = a2 * sc[e] + b2 * cc[e]; }
    }
#pragma unroll
    for (int g = 0; g < 4; ++g) *(LAS u32x2*)(dst + rr * AQ_STR + sub * 4 + 32 * g) = (u32x2){pk2(y[g][0], y[g][1]), pk2(y[g][2], y[g][3])};
}
__device__ __forceinline__ void vt64_load(const bf16* src0, size_t row_stride, int tid, u32x2 (&x)[4]) {
    const int kg = tid & 15, dg = tid >> 4;
#pragma unroll
    for (int i = 0; i < 4; ++i) x[i] = *(const u32x2*)(src0 + (size_t)(4 * kg + i) * row_stride + 4 * dg);
}
__device__ __forceinline__ void vt64_store(const u32x2 (&x)[4], LAS bf16* VT, int tid) {
    const int kg = tid & 15, dg = tid >> 4;
    const unsigned e0[4] = {x[0].x & 0xffffu, x[1].x & 0xffffu, x[2].x & 0xffffu, x[3].x & 0xffffu};
    const unsigned e1[4] = {x[0].x >> 16, x[1].x >> 16, x[2].x >> 16, x[3].x >> 16};
    const unsigned e2[4] = {x[0].y & 0xffffu, x[1].y & 0xffffu, x[2].y & 0xffffu, x[3].y & 0xffffu};
    const unsigned e3[4] = {x[0].y >> 16, x[1].y >> 16, x[2].y >> 16, x[3].y >> 16};
    *(LAS u32x2*)(VT + (4 * dg + 0) * AV_STR + 4 * kg) = (u32x2){e0[0] | (e0[1] << 16), e0[2] | (e0[3] << 16)};
    *(LAS u32x2*)(VT + (4 * dg + 1) * AV_STR + 4 * kg) = (u32x2){e1[0] | (e1[1] << 16), e1[2] | (e1[3] << 16)};
    *(LAS u32x2*)(VT + (4 * dg + 2) * AV_STR + 4 * kg) = (u32x2){e2[0] | (e2[1] << 16), e2[2] | (e2[3] << 16)};
    *(LAS u32x2*)(VT + (4 * dg + 3) * AV_STR + 4 * kg) = (u32x2){e3[0] | (e3[1] << 16), e3[2] | (e3[3] << 16)};
}

__device__ __forceinline__ void attn_unit(int unit, const bf16* P, const float* q_g, const float* k_g, const float* sink, const float* RC, const float* RS, bf16* MIX,
                                          LAS unsigned char* lds, int tid, int lane, int wave) {
    const int b = unit >> 7, kvh = (unit >> 6) & 1, qb = unit & 63, q0 = qb * 64;
    LAS bf16* QS = (LAS bf16*)(lds + AT_OFF_Q); LAS bf16* KS = (LAS bf16*)(lds + AT_OFF_K); LAS bf16* VT = (LAS bf16*)(lds + AT_OFF_VT);
    const int fr = lane & 15, quad = lane >> 4, g = wave >> 1, th = wave & 1;
    const float LOG2E = 1.4426950408889634f, cscale = 0.08838834764831845f * LOG2E;
    __syncthreads();
    auto tile_s0 = [&](int ti) -> int { return ti < 4 ? 64 * ti : q0 - 128 + 64 * (ti - 4); };
    auto tile_row0 = [&](int ti) -> size_t { const int s0 = tile_s0(ti); return ti < 4 ? (size_t)(NLAT + b * LC + s0) : (size_t)(b * TT + s0); };
    auto next_tile = [&](int ti) -> int { ++ti; while (ti < 9 && ti >= 4 && (tile_s0(ti) < 0 || tile_s0(ti) >= TT)) ++ti; return ti; };
    u32x2 kraw[4], vraw[4];
#pragma unroll 1
    for (int gp = 0; gp < 2; ++gp) { u32x2 qraw[2][4];
#pragma unroll
      for (int gg = 0; gg < 2; ++gg) rows64_load(P + (size_t)(b * TT + q0) * INC + C_AQ + (kvh * 4 + 2 * gp + gg) * 128, INC, tid, qraw[gg]);
      if (gp == 1) { rows64_load(P + tile_row0(0) * INC + C_AK + kvh * 128, INC, tid, kraw); vt64_load(P + tile_row0(0) * INC + C_AV + kvh * 128, INC, tid, vraw); }
#pragma unroll
      for (int gg = 0; gg < 2; ++gg) rows64_proc(qraw[gg], q0, true, q_g, RC, RS, QS + (2 * gp + gg) * 64 * AQ_STR, tid, cscale); }
    __syncthreads();
    float m[2], l[2];
    m[0] = m[1] = sink[kvh * 4 + g] * LOG2E; l[0] = l[1] = 1.f;
    f32x4 oacc[8][2];
#pragma unroll
    for (int dt = 0; dt < 8; ++dt) { oacc[dt][0] = (f32x4){0.f, 0.f, 0.f, 0.f}; oacc[dt][1] = (f32x4){0.f, 0.f, 0.f, 0.f}; }
#pragma unroll 1
    for (int ti = 0; ti < 9; ) {
        const bool isctx = ti < 4; const int s0 = tile_s0(ti);
        __syncthreads();
        rows64_proc(kraw, s0, !isctx, k_g, RC, RS, KS, tid, 1.f);
        vt64_store(vraw, VT, tid);
        __syncthreads();
        const int tn = next_tile(ti);
        if (tn < 9) { rows64_load(P + tile_row0(tn) * INC + C_AK + kvh * 128, INC, tid, kraw); vt64_load(P + tile_row0(tn) * INC + C_AV + kvh * 128, INC, tid, vraw); }
        ti = tn;
        f32x4 sacc[2][4];
#pragma unroll
        for (int kt = 0; kt < 4; ++kt) { sacc[0][kt] = (f32x4){0.f, 0.f, 0.f, 0.f}; sacc[1][kt] = (f32x4){0.f, 0.f, 0.f, 0.f}; }
#pragma unroll
        for (int ks = 0; ks < 4; ++ks) {
            const bf16x8 q0f = *(const LAS bf16x8*)(QS + (g * 64 + th * 32 + fr) * AQ_STR + 32 * ks + 8 * quad), q1f = *(const LAS bf16x8*)(QS + (g * 64 + th * 32 + 16 + fr) * AQ_STR + 32 * ks + 8 * quad);
#pragma unroll
            for (int kt = 0; kt < 4; ++kt) { const bf16x8 kf = *(const LAS bf16x8*)(KS + (16 * kt + fr) * AQ_STR + 32 * ks + 8 * quad);
                sacc[0][kt] = MFMA16(kf, q0f, sacc[0][kt]); sacc[1][kt] = MFMA16(kf, q1f, sacc[1][kt]); }
        }
        bf16x8 pf[2][2];
        const bool edge = !isctx && (s0 < q0 - 64 || s0 > q0 + 64);
#pragma unroll
        for (int qt = 0; qt < 2; ++qt) {
            const int tq = q0 + th * 32 + qt * 16 + fr;
            if (edge) {
#pragma unroll
                for (int kt = 0; kt < 4; ++kt)
#pragma unroll
                    for (int r = 0; r < 4; ++r) { const int d = tq - (s0 + 16 * kt + 4 * quad + r); if (d > 128 || d < -128) sacc[qt][kt][r] = -1.0e30f; }
            }
            float mx = fmaxf(fmaxf(sacc[qt][0][0], sacc[qt][0][1]), fmaxf(sacc[qt][0][2], sacc[qt][0][3]));
#pragma unroll
            for (int kt = 1; kt < 4; ++kt) mx = fmaxf(mx, fmaxf(fmaxf(sacc[qt][kt][0], sacc[qt][kt][1]), fmaxf(sacc[qt][kt][2], sacc[qt][kt][3])));
            mx = fmaxf(mx, __shfl_xor(mx, 16)); mx = fmaxf(mx, __shfl_xor(mx, 32));
            if (__any(mx > m[qt])) {
                const float mn = fmaxf(m[qt], mx), alpha = __builtin_amdgcn_exp2f(m[qt] - mn);
                l[qt] *= alpha; m[qt] = mn;
#pragma unroll
                for (int dt = 0; dt < 8; ++dt) oacc[dt][qt] *= alpha;
            }
            const float mq = m[qt]; float rs = 0.f;
#pragma unroll
            for (int kt = 0; kt < 4; ++kt)
#pragma unroll
                for (int r = 0; r < 4; ++r) { const float p = __builtin_amdgcn_exp2f(sacc[qt][kt][r] - mq); sacc[qt][kt][r] = p; rs += p; }
            rs += __shfl_xor(rs, 16); rs += __shfl_xor(rs, 32);
            l[qt] += rs;
#pragma unroll
            for (int s = 0; s < 2; ++s) { u32x4 w; w.x = pk2(sacc[qt][2 * s][0], sacc[qt][2 * s][1]); w.y = pk2(sacc[qt][2 * s][2], sacc[qt][2 * s][3]);
                w.z = pk2(sacc[qt][2 * s + 1][0], sacc[qt][2 * s + 1][1]); w.w = pk2(sacc[qt][2 * s + 1][2], sacc[qt][2 * s + 1][3]); pf[qt][s] = __builtin_bit_cast(bf16x8, w); }
        }
#pragma unroll
        for (int dt = 0; dt < 8; ++dt)
#pragma unroll
            for (int s = 0; s < 2; ++s) {
                const u32x2 v0 = *(const LAS u32x2*)(VT + (16 * dt + fr) * AV_STR + 32 * s + 4 * quad), v1 = *(const LAS u32x2*)(VT + (16 * dt + fr) * AV_STR + 32 * s + 16 + 4 * quad);
                const bf16x8 vf = __builtin_bit_cast(bf16x8, (u32x4){v0.x, v0.y, v1.x, v1.y});
                oacc[dt][0] = MFMA16(vf, pf[0][s], oacc[dt][0]); oacc[dt][1] = MFMA16(vf, pf[1][s], oacc[dt][1]);
            }
    }
#pragma unroll
    for (int qt = 0; qt < 2; ++qt) {
        const float inv = 1.f / l[qt]; const int tq = q0 + th * 32 + qt * 16 + fr;
        bf16* orow = MIX + (size_t)(b * TT + tq) * DM + 1024 + (kvh * 4 + g) * 128;
#pragma unroll
        for (int dt = 0; dt < 8; ++dt) { const f32x4 o = oacc[dt][qt] * inv; *(u32x2*)(orow + 16 * dt + 4 * quad) = (u32x2){pk2(o.x, o.y), pk2(o.z, o.w)}; }
    }
}


__device__ __forceinline__ void readout_row(int row, const float* OF, const float* OB, const bf16* P, const float* ng, bf16* MIX, int lane) {
#pragma unroll
    for (int j = 0; j < 4; ++j) {
        const int e = 4 * lane + 256 * j;
        const f32x4 a = *(const f32x4*)(OF + (size_t)row * 1024 + e), c = *(const f32x4*)(OB + (size_t)row * 1024 + e); const f32x4 o = a + c;
        float ss = (o.x * o.x + o.y * o.y) + (o.z * o.z + o.w * o.w);
        ss += __shfl_xor(ss, 1); ss += __shfl_xor(ss, 2); ss += __shfl_xor(ss, 4); ss += __shfl_xor(ss, 8); ss += __shfl_xor(ss, 16);
        const float rstd = rsqrtf(ss * (1.f / 128.f) + RMS_EPS);
        const f32x4 gm = *(const f32x4*)(ng + (e & 127));
        const u32x2 gw = *(const u32x2*)(P + (size_t)row * INC + C_G + e);
        const float g0 = __uint_as_float(gw.x << 16), g1 = __uint_as_float(gw.x & 0xffff0000u), g2 = __uint_as_float(gw.y << 16), g3 = __uint_as_float(gw.y & 0xffff0000u);
        *(u32x2*)(MIX + (size_t)row * DM + e) = (u32x2){pk2(o.x * rstd * gm.x * siluf_(g0), o.y * rstd * gm.y * siluf_(g1)), pk2(o.z * rstd * gm.z * siluf_(g2), o.w * rstd * gm.w * siluf_(g3))};
    }
}

#define XB_TMO      128
#define XB_XCNT(j)  (256  + 64 * (j))
#define XB_XSUB(j)  (1280 + 64 * (j))
#define XB_XGEN(j)  (2304 + 64 * (j))
#define XB_TOP      3328
#define XB_TOPGEN   3392
#define XCD_BAR_WORDS 3456
#define XB_SPIN_CAP (1u << 18)

__device__ __forceinline__ unsigned xb_ld(unsigned* p)              { return __hip_atomic_load(p, __ATOMIC_RELAXED, __HIP_MEMORY_SCOPE_AGENT); }
__device__ __forceinline__ unsigned xb_add(unsigned* p, unsigned v) { return __hip_atomic_fetch_add(p, v, __ATOMIC_RELAXED, __HIP_MEMORY_SCOPE_AGENT); }
__device__ __forceinline__ unsigned xb_xcc_id() { return (unsigned)__builtin_amdgcn_s_getreg((3 << 11) | 20) & 0xFu; }
#define XB_SPIN(cond, bar) do { unsigned _sp = 0; while (cond) { __builtin_amdgcn_s_sleep(1); \
    if ((++_sp & 255u) == 0u) { if (xb_ld(&(bar)[XB_TMO])) break; if (_sp > XB_SPIN_CAP) { atomicAdd(&(bar)[XB_TMO], 1u); break; } } } } while (0)

struct XcdBarrier {
    unsigned* bar; unsigned x;
    volatile LAS unsigned* st;
};

__device__ __forceinline__ XcdBarrier xcd_barrier_post(unsigned* bar, volatile LAS unsigned* st) {
    XcdBarrier b; b.bar = bar; b.x = xb_xcc_id(); b.st = st;
    if (threadIdx.x == 0) (void)xb_add(&bar[XB_XCNT(b.x)], 1u);
    return b;
}
__device__ __forceinline__ void xcd_barrier_complete(unsigned* bar, unsigned x, unsigned& nloc, unsigned& nx) {
    const unsigned G = gridDim.x * gridDim.y * gridDim.z;
    unsigned sum, cnt, mine, sp = 0u;
    for (;;) {
        sum = 0u; cnt = 0u; mine = 0u;
#pragma unroll
        for (unsigned j = 0; j < 16; ++j) { const unsigned c = xb_ld(&bar[XB_XCNT(j)]); sum += c; cnt += (c > 0u) ? 1u : 0u; mine = (j == x) ? c : mine; }
        if (sum == G) break;
        __builtin_amdgcn_s_sleep(1);
        if ((++sp & 255u) == 0u) { if (xb_ld(&bar[XB_TMO])) break; if (sp > XB_SPIN_CAP) { atomicAdd(&bar[XB_TMO], 1u); break; } }
    }
    nloc = mine > 0u ? mine : 1u; nx = cnt > 0u ? cnt : 1u;
}

__device__ __forceinline__ void xcd_barrier(const XcdBarrier& b) {
    asm volatile("s_waitcnt vmcnt(0)" ::: "memory");
    __syncthreads();
    if (threadIdx.x == 0) {
        unsigned* bar = b.bar;
        __builtin_amdgcn_s_waitcnt(0);
        unsigned nloc = b.st[0], nx = b.st[1];
        if (nloc == 0u) { xcd_barrier_complete(bar, b.x, nloc, nx); b.st[0] = nloc; b.st[1] = nx; }
        const unsigned old = xb_add(&bar[XB_XSUB(b.x)], 1u);
        const unsigned gen = old / nloc;
        if (old + 1u == (gen + 1u) * nloc) {
            __builtin_amdgcn_fence(__ATOMIC_RELEASE, "agent");
            asm volatile("s_waitcnt vmcnt(0)" ::: "memory");
            const unsigned og = xb_add(&bar[XB_TOP], 1u);
            const unsigned tg = og / nx;
            if (og + 1u == (tg + 1u) * nx) xb_add(&bar[XB_TOPGEN], 1u);
            else XB_SPIN(xb_ld(&bar[XB_TOPGEN]) == tg, bar);
            __builtin_amdgcn_fence(__ATOMIC_ACQUIRE, "agent");
            xb_add(&bar[XB_XGEN(b.x)], 1u);
            asm volatile("s_waitcnt vmcnt(0)" ::: "memory");
        } else {
            XB_SPIN(xb_ld(&bar[XB_XGEN(b.x)]) == gen, bar);
            __builtin_amdgcn_fence(__ATOMIC_ACQUIRE, "agent");
            asm volatile("s_waitcnt vmcnt(0)" ::: "memory");
        }
    }
    __syncthreads();
}


constexpr size_t WS_BAR = 512 * 1024, BAR_BYTES = 16384;
constexpr int LDS_MISC = 147456;

struct Args { const float* in[17]; float* out; unsigned char* ws; int ph_lo, ph_hi; };
__global__ void __launch_bounds__(NTHR, 2) fwd_megakernel(Args args) {
    extern __shared__ __attribute__((aligned(16))) unsigned char lds_raw[];
    LAS unsigned char* lds = (LAS unsigned char*)lds_raw;
    cg::grid_group grid = cg::this_grid();
    const int tid = threadIdx.x, lane = tid & 63, wave = __builtin_amdgcn_readfirstlane(tid >> 6);
    const int blk = blockIdx.x, G = gridDim.x, gw = blk * NWAVES + wave, NGW = G * NWAVES;
    unsigned char* ws = args.ws;
    const float* x = args.in[0]; const float* ctx = args.in[2];
    float* MOD = (float*)(ws + WS_MOD); const float* RC = (const float*)(ws + WS_ROPE); const float* RS = RC + 2048;
    bf16* H = (bf16*)(ws + WS_H); bf16* P = (bf16*)(ws + WS_P); bf16* ACT = (bf16*)(ws + WS_ACT); bf16* MIX = (bf16*)(ws + WS_MIX);
    float* OF = (float*)(ws + WS_OF); float* OB = (float*)(ws + WS_OB);
    const int lo = args.ph_lo, hi = args.ph_hi;
    volatile LAS unsigned* bst = (volatile LAS unsigned*)(lds + LDS_MISC);
    if (tid < 2) bst[tid] = 0u;
    __syncthreads();
    XcdBarrier xbar; xbar.bar = (unsigned*)(ws + WS_BAR); xbar.x = 0; xbar.st = bst;
#define IN(k) (lo <= (k) && (k) < hi)
#ifdef PROBE_DUP
#define REP(k) for (int rep_ = 0; rep_ < ((PROBE_DUP) == (k) ? 2 : 1); ++rep_)
#else
#define REP(k)
#endif
#define SEAM(k) do { if (IN(k) && IN((k) + 1)) { \
        if ((k) == 0) { \
            asm volatile("s_waitcnt vmcnt(0) lgkmcnt(0)" ::: "memory"); __syncthreads(); \
            if (tid == 0) { __builtin_amdgcn_fence(__ATOMIC_RELEASE, "agent"); asm volatile("s_waitcnt vmcnt(0)" ::: "memory"); } \
            grid.sync(); \
            if (tid == 0) { __builtin_amdgcn_fence(__ATOMIC_ACQUIRE, "agent"); asm volatile("s_waitcnt vmcnt(0)" ::: "memory"); } \
            __syncthreads(); \
        } else { xcd_barrier(xbar); } } } while (0)

    if (IN(0)) REP(0) { if (blk == 0) for (int i = tid; i < (int)(BAR_BYTES / 4); i += NTHR) ((unsigned*)(ws + WS_BAR))[i] = 0u;
        phase0(args.in, ws, lds, tid, lane, wave); }
    SEAM(0);
    if (lo == 0 && hi > 1) xbar = xcd_barrier_post((unsigned*)(ws + WS_BAR), bst);
    if (IN(1)) REP(1) {
        for (int row = gw; row < MROWS; row += NGW) {
            const float* src = row < NLAT ? x + (size_t)row * DM : ctx + (size_t)(row - NLAT) * DM; const int v = row < NLAT ? row / TT : 2;
            norm_mod_row(src, args.in[6], MOD + v * NMODV, MOD + v * NMODV + DM, H + (size_t)row * DM, lane);
        }
    }
    SEAM(1);
    if (IN(2)) REP(2) {
        pg8::Gemm g{H, (const bf16*)(ws + WS_WIN), MROWS, INC, DM}; pg8::StaticOrder S; S.init(MROWS, INC, G, blk);
        pg8::EpiBf16<0> E{P, INC, nullptr, 0, 0, 1.f};
        pg8::gemm_phase<pg8::EpiBf16<0>, pg8::StaticOrder, true, true>(lds, g, S, E);
        { const int nwg = (MROWS / 256) * (INC / 256), nfull = nwg % G;
          const int first = nfull != 0 ? nfull : 0;
          if (blk >= first) convert_weights(6, args.in, ws, lds, (blk - first) * NWAVES + wave, (G - first) * NWAVES, lane, wave); }
    }
    SEAM(2);
    if (IN(3)) REP(3) { scan_prep(P, args.in[9], ws, args.out, lds, tid, lane, wave); }
    SEAM(3);
    if (IN(4)) REP(4) {
        if (G > NSCAN) { if (blk < NSCAN) {
                             REP(40) scan_apply(blk, ws, args.out, OF, OB, lds, tid, lane, wave); }
                         else {
                             REP(41) for (int u = blk - NSCAN; u < 256; u += G - NSCAN) attn_unit(u, P, args.in[11], args.in[12], args.in[13], RC, RS, MIX, lds, tid, lane, wave); }
                         { const int na = G - NSCAN, first1 = 256 - na > 0 ? 256 - na : 0;
                           if (blk >= NSCAN + first1) { __syncthreads(); convert_weights(8, args.in, ws, lds, (blk - NSCAN - first1) * NWAVES + wave, (na - first1) * NWAVES, lane, wave); } } }
        else { for (int it = blk; it < NSCAN; it += G) scan_apply(it, ws, args.out, OF, OB, lds, tid, lane, wave);
               for (int u = blk; u < 256; u += G) attn_unit(u, P, args.in[11], args.in[12], args.in[13], RC, RS, MIX, lds, tid, lane, wave); }
    }
    SEAM(4);
    if (IN(5)) REP(5) { for (int row = gw; row < NLAT; row += NGW) readout_row(row, OF, OB, P, args.in[10], MIX, lane); }
    SEAM(5);
    if (IN(6)) REP(6) {
        pg8::Gemm g{MIX, (const bf16*)(ws + WS_WOUT), NLAT, DM, DM}; pg8::StaticOrder S; S.init(NLAT, DM, G, blk);
        EpiResGate E{x, args.out, MOD + 2 * DM};
        pg8::gemm_phase<EpiResGate, pg8::StaticOrder, true, true>(lds, g, S, E);
    }
    SEAM(6);
    if (IN(7)) REP(7) {
        for (int row = gw; row < NLAT; row += NGW) { const int v = row / TT;
            norm_mod_row(args.out + (size_t)row * DM, args.in[7], MOD + v * NMODV + 3 * DM, MOD + v * NMODV + 4 * DM, H + (size_t)row * DM, lane); }
    }
    SEAM(7);
    if (IN(8)) REP(8) {
        pg8::Gemm g{H, (const bf16*)(ws + WS_WGU), NLAT, 2 * DFF, DM}; pg8::StaticOrder S; S.init(NLAT, 2 * DFF, G, blk);
        EpiSwiGLU E{ACT};
        pg8::gemm_phase<EpiSwiGLU, pg8::StaticOrder, true, true>(lds, g, S, E);
    }
    SEAM(8);
    if (IN(9)) REP(9) {
        pg8::Gemm g{ACT, (const bf16*)(ws + WS_WDN), NLAT, DM, DFF}; pg8::StaticOrder S; S.init(NLAT, DM, G, blk);
        EpiResGate E{args.out, args.out, MOD + 5 * DM};
        pg8::gemm_phase<EpiResGate, pg8::StaticOrder, true, true>(lds, g, S, E);
    }
#undef IN
#undef SEAM
}

extern "C" void kernel_launch(void* const* d_in, const int* in_sizes, int n_in, void* d_out, int out_size, void* d_ws, size_t ws_size, hipStream_t stream) {
    static int grid = 0;
    if (grid == 0) {
        if (n_in != 17 || ws_size < WS_END) { fprintf(stderr, "kernel_launch: unexpected n_in %d or ws_size %zu\n", n_in, ws_size); grid = -1; return; }
        int dev = 0, cus = 0, per_cu = 0;
        hipGetDevice(&dev); hipDeviceGetAttribute(&cus, hipDeviceAttributeMultiprocessorCount, dev);
        if (hipFuncSetAttribute((const void*)fwd_megakernel, hipFuncAttributeMaxDynamicSharedMemorySize, LDS_BYTES) != hipSuccess) { fprintf(stderr, "hipFuncSetAttribute failed\n"); grid = -1; return; }
        if (hipOccupancyMaxActiveBlocksPerMultiprocessor(&per_cu, (const void*)fwd_megakernel, NTHR, LDS_BYTES) != hipSuccess || per_cu < 1) { fprintf(stderr, "occupancy query failed (%d)\n", per_cu); (void)hipGetLastError(); per_cu = 1; }
        grid = cus * per_cu;
    }
    if (grid < 0) return;
    Args a{};
    for (int i = 0; i < 17; ++i) a.in[i] = (const float*)d_in[i];
    a.out = (float*)d_out; a.ws = (unsigned char*)d_ws; a.ph_lo = 0; a.ph_hi = 10;
#ifndef N_LAUNCH
#define N_LAUNCH 9
#endif
#if N_LAUNCH == 1
    void* kargs[] = {&a};
    hipError_t e = hipLaunchCooperativeKernel((const void*)fwd_megakernel, dim3(grid), dim3(NTHR), kargs, LDS_BYTES, stream);
    if (e != hipSuccess) fprintf(stderr, "cooperative launch failed: %s (grid %d)\n", hipGetErrorString(e), grid);
#else
    for (int p = 0; p < 10; ++p) { a.ph_lo = p; a.ph_hi = p + 1; hipLaunchKernelGGL(fwd_megakernel, dim3(grid), dim3(NTHR), LDS_BYTES, stream, a); }
#endif
}
```
